# Optimizing an MI355X kernel written in HIP

```python
import math
import jax
import jax.numpy as jnp
from jax import lax
import numpy as np

D_MODEL = 4096
BATCH = 2
SEQ = 8192
DEPTH = 2

F32 = jnp.float32
GRID_W = 64
CTX_LEN = 256
EPS = 1e-6
ATT_WIDTH = D_MODEL // 2
HEAD_DIM = 128
N_HEADS = ATT_WIDTH // HEAD_DIM
N_KV_HEADS = N_HEADS // 4
Q_PER_KV = N_HEADS // N_KV_HEADS
KV_WIDTH = N_KV_HEADS * HEAD_DIM
Q_BLOCK = 128
ROPE_THETA = 10000.0
SSM_WIDTH = D_MODEL // 2
SSM_GROUP = 16
SSM_GROUPS = SSM_WIDTH // SSM_GROUP
SSM_STATE = 64
SSM_CHUNK = 16
DT_MIN = 1e-3
DT_MAX = 1e-1
CONV_CH = D_MODEL
CONV_K = 3
EVEN_PARTS = (("q", ATT_WIDTH), ("k", KV_WIDTH), ("v", KV_WIDTH), ("g_att", ATT_WIDTH), ("u", SSM_WIDTH), ("g_ssm", SSM_WIDTH))
EVEN_IN = 2 * ATT_WIDTH + 2 * KV_WIDTH + 2 * SSM_WIDTH
ODD_IN = 4 * CONV_CH

kernel_name = "hybrid_gqa_s5_shortconv_dit"


def rms_norm(x, w):
    xf = x.astype(F32)
    y = xf * lax.rsqrt(jnp.mean(xf * xf, axis=-1, keepdims=True) + EPS)
    return (y * w.astype(F32)).astype(x.dtype)


def ada_mod(cond, w_mod, b_mod):
    m = (jax.nn.silu(cond) @ w_mod + b_mod)[..., None, :]
    return jnp.split(m, 3, axis=-1)


def modulate(h, norm_w, shift, scale):
    return rms_norm(h, norm_w) * (1 + scale) + shift


def even_part(t, name):
    off = 0
    for part, width in EVEN_PARTS:
        if part == name:
            return t[..., off:off + width]
        off += width
    raise KeyError(name)


def axial_rope_tables(n_tok):
    rows = n_tok // GRID_W
    r, col = jnp.meshgrid(jnp.arange(rows, dtype=F32), jnp.arange(GRID_W, dtype=F32), indexing="ij")
    axis_dim = HEAD_DIM // 2
    inv_freq = ROPE_THETA ** (-jnp.arange(0, axis_dim, 2, dtype=F32) / axis_dim)
    ang = jnp.stack([r.reshape(-1)[:, None] * inv_freq, col.reshape(-1)[:, None] * inv_freq], axis=1)
    return jnp.cos(ang), jnp.sin(ang)


def apply_axial_rope(t, cos, sin):
    xs = t.astype(F32).reshape(t.shape[:-1] + (2, 2, HEAD_DIM // 4))
    x1, x2 = xs[..., 0, :], xs[..., 1, :]
    cs, sn = cos[None, :, None], sin[None, :, None]
    out = jnp.stack([x1 * cs - x2 * sn, x2 * cs + x1 * sn], axis=-2)
    return out.reshape(t.shape).astype(t.dtype)


def _attend(qg, k, v):
    s = jnp.einsum("bqkgd,bskd->bkgqs", qg, k, preferred_element_type=F32) * (HEAD_DIM ** -0.5)
    p = jax.nn.softmax(s, axis=-1).astype(v.dtype)
    return jnp.einsum("bkgqs,bskd->bqkgd", p, v)


def latent_attention(q, k, v, k_ctx, v_ctx):
    b, n = q.shape[0], q.shape[1]
    k_all = jnp.concatenate([k_ctx, k], axis=1)
    v_all = jnp.concatenate([v_ctx, v], axis=1)
    qb = q.reshape(b, n // Q_BLOCK, Q_BLOCK, N_KV_HEADS, Q_PER_KV, HEAD_DIM).swapaxes(0, 1)
    o = lax.map(lambda blk: _attend(blk, k_all, v_all), qb)
    return o.swapaxes(0, 1).reshape(b, n, ATT_WIDTH)


def s5_discretize(lam_re, lam_im, log_dt, b_re, b_im):
    dt = jnp.exp(log_dt.astype(F32))[:, None]
    lr, li = lam_re.astype(F32), lam_im.astype(F32)
    mag = jnp.exp(lr * dt)
    a_re, a_im = mag * jnp.cos(li * dt), mag * jnp.sin(li * dt)
    den = lr * lr + li * li
    n_re = a_re - 1.0
    coef_re = ((n_re * lr + a_im * li) / den)[..., None]
    coef_im = ((a_im * lr - n_re * li) / den)[..., None]
    br, bi = b_re.astype(F32), b_im.astype(F32)
    return (a_re, a_im, coef_re * br - coef_im * bi, coef_re * bi + coef_im * br)


def _ssm_combine(e1, e2):
    a1r, a1i, b1r, b1i = e1
    a2r, a2i, b2r, b2i = e2
    return (a1r * a2r - a1i * a2i, a1r * a2i + a1i * a2r,
            a2r * b1r - a2i * b1i + b2r, a2r * b1i + a2i * b1r + b2i)


def s5_scan(u, disc, h0, reverse):
    a_re, a_im, bb_re, bb_im = disc
    bu_re = jnp.einsum("blgi,gpi->blgp", u, bb_re)
    bu_im = jnp.einsum("blgi,gpi->blgp", u, bb_im)
    if h0 is not None:
        h0_re, h0_im = h0
        first = -1 if reverse else 0
        bu_re = bu_re.at[:, first].add(a_re * h0_re - a_im * h0_im)
        bu_im = bu_im.at[:, first].add(a_re * h0_im + a_im * h0_re)
    elems = (jnp.broadcast_to(a_re, bu_re.shape), jnp.broadcast_to(a_im, bu_im.shape), bu_re, bu_im)
    _, _, h_re, h_im = lax.associative_scan(_ssm_combine, elems, reverse=reverse, axis=1)
    return h_re, h_im


def s5_readout(h_re, h_im, c_re, c_im):
    return jnp.einsum("blgp,gip->blgi", h_re, c_re) - jnp.einsum("blgp,gip->blgi", h_im, c_im)


def _chunk_groups(t, axis):
    n_chunks = SSM_GROUPS // SSM_CHUNK
    t = t.reshape(t.shape[:axis] + (n_chunks, SSM_CHUNK) + t.shape[axis + 1:])
    return jnp.moveaxis(t, axis, 0)


def s5_latent(u, fwd, bwd, h0_fwd, h0_bwd):
    b, n = u.shape[0], u.shape[1]
    xs = (_chunk_groups(u, 2),
          tuple(_chunk_groups(t, 1) for t in h0_fwd), tuple(_chunk_groups(t, 1) for t in h0_bwd),
          tuple(_chunk_groups(t, 0) for t in fwd), tuple(_chunk_groups(t, 0) for t in bwd))

    def chunk(args):
        uc, hf, hb, pf, pb = args
        y = s5_readout(*s5_scan(uc, pf[:4], hf, False), *pf[4:])
        return y + s5_readout(*s5_scan(uc, pb[:4], hb, True), *pb[4:])

    y = lax.map(chunk, xs)
    return jnp.moveaxis(y, 0, 2).reshape(b, n, SSM_WIDTH)


def ssm_glu(y, w_glu, b_glu):
    y = jax.nn.gelu(y)
    return y * jax.nn.sigmoid(y @ w_glu + b_glu)


def attn_ssm_layer(h, hc, p, c, c_ctx, cos, sin, ctx_out):
    b, n, _ = h.shape
    nc = hc.shape[1]
    shift, scale, gate = ada_mod(c, p["w_mod"], p["b_mod"])
    shift_c, scale_c, gate_c = ada_mod(c_ctx, p["w_mod"], p["b_mod"])
    xn = modulate(h, p["norm_w"], shift, scale)
    xcn = modulate(hc, p["norm_w"], shift_c, scale_c)
    w_in = p["w_in"]
    z = xn @ w_in

    q = apply_axial_rope(rms_norm(even_part(z, "q").reshape(b, n, N_HEADS, HEAD_DIM), p["q_norm_w"]), cos, sin)
    k = apply_axial_rope(rms_norm(even_part(z, "k").reshape(b, n, N_KV_HEADS, HEAD_DIM), p["k_norm_w"]), cos, sin)
    v = even_part(z, "v").reshape(b, n, N_KV_HEADS, HEAD_DIM)
    kc = rms_norm((xcn @ even_part(w_in, "k")).reshape(b, nc, N_KV_HEADS, HEAD_DIM), p["k_norm_w"])
    vc = (xcn @ even_part(w_in, "v")).reshape(b, nc, N_KV_HEADS, HEAD_DIM)
    att = latent_attention(q, k, v, kc, vc)

    fwd = s5_discretize(*p["fwd"][:5]) + (p["fwd"][5].astype(F32), p["fwd"][6].astype(F32))
    bwd = s5_discretize(*p["bwd"][:5]) + (p["bwd"][5].astype(F32), p["bwd"][6].astype(F32))
    d_skip = p["ssm_d"].astype(F32)
    u = even_part(z, "u").astype(F32)
    uc = (xcn @ even_part(w_in, "u")).astype(F32)
    uc_g = uc.reshape(b, nc, SSM_GROUPS, SSM_GROUP)
    hcf_re, hcf_im = s5_scan(uc_g, fwd[:4], None, False)
    hcb_re, hcb_im = s5_scan(uc_g, bwd[:4], None, True)
    y = s5_latent(u.reshape(b, n, SSM_GROUPS, SSM_GROUP), fwd, bwd,
                  (hcf_re[:, -1], hcf_im[:, -1]), (hcb_re[:, 0], hcb_im[:, 0]))
    ssm = ssm_glu((y + d_skip * u).astype(h.dtype), p["w_glu"], p["b_glu"])

    mixed = jnp.concatenate([att * jax.nn.silu(even_part(z, "g_att")),
                             ssm * jax.nn.silu(even_part(z, "g_ssm"))], axis=-1)
    h_new = h + gate * (mixed @ p["w_out"])

    if ctx_out:
        qc = rms_norm((xcn @ even_part(w_in, "q")).reshape(b, nc, N_HEADS, HEAD_DIM), p["q_norm_w"])
        att_c = _attend(qc.reshape(b, nc, N_KV_HEADS, Q_PER_KV, HEAD_DIM), kc, vc).reshape(b, nc, ATT_WIDTH)
        yc = (s5_readout(hcf_re, hcf_im, *fwd[4:]) + s5_readout(hcb_re, hcb_im, *bwd[4:])).reshape(b, nc, SSM_WIDTH)
        ssm_c = ssm_glu((yc + d_skip * uc).astype(hc.dtype), p["w_glu"], p["b_glu"])
        mixed_c = jnp.concatenate([att_c * jax.nn.silu(xcn @ even_part(w_in, "g_att")),
                                   ssm_c * jax.nn.silu(xcn @ even_part(w_in, "g_ssm"))], axis=-1)
        hc = hc + gate_c * (mixed_c @ p["w_out"])
    return h_new, hc


def short_conv_mixer(xn, w_in, conv_w, conv_b, w_out):
    n = xn.shape[1]
    b_gate, c_gate, xin, g = jnp.split(xn @ w_in, 4, axis=-1)
    y = c_gate * xin
    pad = CONV_K // 2
    yp = jnp.pad(y, ((0, 0), (pad, pad), (0, 0)))
    conv = conv_b
    for j in range(CONV_K):
        conv = conv + yp[:, j:j + n] * conv_w[j]
    return (b_gate * conv * jax.nn.silu(g)) @ w_out


def shortconv_layer(h, hc, p, c, c_ctx, ctx_out):
    shift, scale, gate = ada_mod(c, p["w_mod"], p["b_mod"])
    xn = modulate(h, p["norm_w"], shift, scale)
    h_new = h + gate * short_conv_mixer(xn, p["w_in"], p["conv_w"], p["conv_b"], p["w_out"])
    if ctx_out:
        shift_c, scale_c, gate_c = ada_mod(c_ctx, p["w_mod"], p["b_mod"])
        xcn = modulate(hc, p["norm_w"], shift_c, scale_c)
        hc = hc + gate_c * short_conv_mixer(xcn, p["w_in"], p["conv_w"], p["conv_b"], p["w_out"])
    return h_new, hc


def setup_inputs(seed: int = 0) -> dict:
    key = jax.random.key(seed)
    ks = iter(jax.random.split(key, 64))

    def nrm(shape, s):
        return jax.random.normal(next(ks), shape, F32) * s

    d = D_MODEL
    g, pst, ci = SSM_GROUPS, SSM_STATE, SSM_GROUP

    def ssm_dir():
        n_idx = jnp.arange(pst, dtype=F32)[None, :]
        lam_re = -0.5 + nrm((g, pst), 0.01)
        lam_im = math.pi * n_idx + nrm((g, pst), 0.01)
        log_dt = jax.random.uniform(next(ks), (g,), F32, math.log(DT_MIN), math.log(DT_MAX))
        b_re = nrm((g, pst, ci), (2.0 * ci) ** -0.5)
        b_im = nrm((g, pst, ci), (2.0 * ci) ** -0.5)
        c_re = nrm((g, ci, pst), (2.0 * pst) ** -0.5)
        c_im = nrm((g, ci, pst), (2.0 * pst) ** -0.5)
        return lam_re, lam_im, log_dt, b_re, b_im, c_re, c_im

    inp = {}
    inp["x"] = nrm((BATCH, SEQ, d), 1.0)
    inp["c"] = nrm((BATCH, d), 1.0)
    inp["ctx"] = nrm((BATCH, CTX_LEN, d), 1.0)
    inp["c_ctx"] = nrm((d,), 1.0)
    inp["l0_norm_w"] = 1.0 + nrm((d,), 0.02)
    inp["l0_w_mod"] = nrm((d, 3 * d), 0.5 * d ** -0.5)
    inp["l0_b_mod"] = nrm((3 * d,), 0.01)
    inp["l0_w_in"] = nrm((d, EVEN_IN), d ** -0.5)
    inp["l0_q_norm_w"] = 1.0 + nrm((HEAD_DIM,), 0.02)
    inp["l0_k_norm_w"] = 1.0 + nrm((HEAD_DIM,), 0.02)
    (inp["l0_fwd_lam_re"], inp["l0_fwd_lam_im"], inp["l0_fwd_log_dt"], inp["l0_fwd_b_re"],
     inp["l0_fwd_b_im"], inp["l0_fwd_c_re"], inp["l0_fwd_c_im"]) = ssm_dir()
    (inp["l0_bwd_lam_re"], inp["l0_bwd_lam_im"], inp["l0_bwd_log_dt"], inp["l0_bwd_b_re"],
     inp["l0_bwd_b_im"], inp["l0_bwd_c_re"], inp["l0_bwd_c_im"]) = ssm_dir()
    inp["l0_ssm_d"] = nrm((SSM_WIDTH,), 1.0)
    inp["l0_w_glu"] = nrm((SSM_WIDTH, SSM_WIDTH), SSM_WIDTH ** -0.5)
    inp["l0_b_glu"] = nrm((SSM_WIDTH,), 0.01)
    inp["l0_w_out"] = nrm((ATT_WIDTH + SSM_WIDTH, d), (ATT_WIDTH + SSM_WIDTH) ** -0.5)
    inp["l1_norm_w"] = 1.0 + nrm((d,), 0.02)
    inp["l1_w_mod"] = nrm((d, 3 * d), 0.5 * d ** -0.5)
    inp["l1_b_mod"] = nrm((3 * d,), 0.01)
    inp["l1_w_in"] = nrm((d, ODD_IN), d ** -0.5)
    inp["l1_conv_w"] = nrm((CONV_K, CONV_CH), CONV_K ** -0.5)
    inp["l1_conv_b"] = nrm((CONV_CH,), 0.01)
    inp["l1_w_out"] = nrm((CONV_CH, d), CONV_CH ** -0.5)
    return inp


def reference(x, c, ctx, c_ctx,
              l0_norm_w, l0_w_mod, l0_b_mod, l0_w_in, l0_q_norm_w, l0_k_norm_w,
              l0_fwd_lam_re, l0_fwd_lam_im, l0_fwd_log_dt, l0_fwd_b_re, l0_fwd_b_im, l0_fwd_c_re, l0_fwd_c_im,
              l0_bwd_lam_re, l0_bwd_lam_im, l0_bwd_log_dt, l0_bwd_b_re, l0_bwd_b_im, l0_bwd_c_re, l0_bwd_c_im,
              l0_ssm_d, l0_w_glu, l0_b_glu, l0_w_out,
              l1_norm_w, l1_w_mod, l1_b_mod, l1_w_in, l1_conv_w, l1_conv_b, l1_w_out):
    cos, sin = axial_rope_tables(x.shape[1])
    layers = (
        dict(norm_w=l0_norm_w, w_mod=l0_w_mod, b_mod=l0_b_mod, w_in=l0_w_in,
             q_norm_w=l0_q_norm_w, k_norm_w=l0_k_norm_w,
             fwd=(l0_fwd_lam_re, l0_fwd_lam_im, l0_fwd_log_dt, l0_fwd_b_re, l0_fwd_b_im, l0_fwd_c_re, l0_fwd_c_im),
             bwd=(l0_bwd_lam_re, l0_bwd_lam_im, l0_bwd_log_dt, l0_bwd_b_re, l0_bwd_b_im, l0_bwd_c_re, l0_bwd_c_im),
             ssm_d=l0_ssm_d, w_glu=l0_w_glu, b_glu=l0_b_glu, w_out=l0_w_out),
        dict(norm_w=l1_norm_w, w_mod=l1_w_mod, b_mod=l1_b_mod, w_in=l1_w_in,
             conv_w=l1_conv_w, conv_b=l1_conv_b, w_out=l1_w_out),
    )
    h, hc = x, ctx
    for i in range(DEPTH):
        ctx_out = any(j % 2 == 0 for j in range(i + 1, DEPTH))
        if i % 2 == 0:
            h, hc = attn_ssm_layer(h, hc, layers[i], c, c_ctx, cos, sin, ctx_out)
        else:
            h, hc = shortconv_layer(h, hc, layers[i], c, c_ctx, ctx_out)
    return h
```

```cpp
#include <hip/hip_runtime.h>
#include <hip/hip_bf16.h>
#include <cstdio>
#include <cstdint>

#ifndef ATT_PROBE
#define ATT_PROBE 0
#endif
#ifndef MK_ONE_LAUNCH
#define MK_ONE_LAUNCH 1
#endif

#define GAS __attribute__((address_space(1)))
#define LAS __attribute__((address_space(3)))
typedef unsigned short bf16_t;
typedef short bf16x8 __attribute__((ext_vector_type(8)));
typedef float f32x4 __attribute__((ext_vector_type(4)));
typedef float f32x2 __attribute__((ext_vector_type(2)));
typedef unsigned u32x4 __attribute__((ext_vector_type(4)));
typedef unsigned u32x2 __attribute__((ext_vector_type(2)));

constexpr int DM = 4096, NBATCH = 2, SEQ = 8192, CTXL = 256;
constexpr int MLAT = NBATCH * SEQ, MCTX = NBATCH * CTXL, MALL = MLAT + MCTX;
constexpr int NIN0 = 9216, NIN1 = 16384, SKV = SEQ + CTXL;
constexpr int NGRP = 128, NST = 64, GCH = 16, TCH = 32, NCHUNK = SEQ / TCH;
constexpr float EPS = 1e-6f;
constexpr float QK_LOG2_SCALE = 0.088388347648318440f * 1.4426950408889634f;
constexpr int NWAVES = 8, NTHREADS = 512;

__device__ __forceinline__ unsigned cvt_pk_bf16(float lo, float hi) { unsigned r; asm volatile("v_cvt_pk_bf16_f32 %0, %1, %2" : "=v"(r) : "v"(lo), "v"(hi)); return r; }
__device__ __forceinline__ float bf_lo(unsigned w) { return __uint_as_float(w << 16); }
__device__ __forceinline__ float bf_hi(unsigned w) { return __uint_as_float(w & 0xffff0000u); }
__device__ __forceinline__ float sigmoidf_(float x) { return __builtin_amdgcn_rcpf(1.0f + __builtin_amdgcn_exp2f(-1.4426950408889634f * x)); }
__device__ __forceinline__ float siluf_(float x) { return x * sigmoidf_(x); }
__device__ __forceinline__ float gelu_tanh_(float y) { const float z = 1.5957691216057308f * (y + 0.044715f * y * y * y); return y * sigmoidf_(z); }
#define LDS_WAIT() asm volatile("s_waitcnt lgkmcnt(0)" ::: "memory")
#define VM_WAIT() asm volatile("s_waitcnt vmcnt(0)" ::: "memory")

namespace pg8 {
constexpr int BM = 256, BK = 64, HALF = 128, HTB = HALF * BK * 2, STAGE_BYTES = 8 * HTB, NXCD = 8, WGM = 8;
__host__ __device__ __forceinline__ int lds_byte(int r, int c) { const int st = (r >> 4) * 2 + (c >> 5), rr = r & 15, cc = c & 31, ob = rr * 64 + cc * 2; return st * 1024 + (ob ^ (((ob >> 9) & 1) << 5)); }
__host__ __device__ __forceinline__ void stage_rc(int b, int& R, int& C) { const int st = b / 1024, sb = b % 1024, swz = sb ^ (((sb >> 9) & 1) << 5); R = (st >> 1) * 16 + swz / 64; C = (st & 1) * 32 + (swz % 64) / 2; }
__host__ __device__ __forceinline__ int perm32(int rho) { const int n = rho >> 4, i = rho & 15; return 8 * (i >> 2) + 4 * n + (i & 3); }

struct Unit { int pm, pn; };
struct Gemm { const bf16_t* A; const bf16_t* Bt; int lda, ldb, K, nt8; };

struct StaticOrder {
    int nM, nN, nwg, G, c;
    __host__ __device__ void init(int M, int N, int G_, int c_) { nM = M / BM; nN = N / BM; nwg = nM * nN; G = G_; c = c_; }
    __host__ __device__ bool next(int i, Unit& u) const {
        const long L = (long)i * G + c; if (L >= nwg) return false;
        int wgid = (int)L; { const int q = nwg / NXCD, r = nwg % NXCD, xcd = wgid % NXCD, off = wgid / NXCD; wgid = (xcd < r ? xcd * (q + 1) : r * (q + 1) + (xcd - r) * q) + off; }
        const int nig = WGM * nN, gid = wgid / nig, fm = gid * WGM, gsz = (nM - fm) < WGM ? (nM - fm) : WGM;
        u.pm = fm + ((wgid % nig) % gsz); u.pn = (wgid % nig) / gsz; return true;
    }
};

typedef int v4i_t __attribute__((ext_vector_type(4)));
typedef int v8i_t __attribute__((ext_vector_type(8)));
__device__ __forceinline__ v8i_t cat8(bf16x8 lo, bf16x8 hi) { const v4i_t a = __builtin_bit_cast(v4i_t, lo), b = __builtin_bit_cast(v4i_t, hi); return __builtin_shufflevector(a, b, 0, 1, 2, 3, 4, 5, 6, 7); }
template <class Epi, class Sched, int MODE = 0>
__device__ __forceinline__ void gemm_phase(LAS unsigned char* lds, const Gemm g, const Sched& S, const Epi& E) {
    const int tid = threadIdx.x, wid = __builtin_amdgcn_readfirstlane(tid >> 6), lane = tid & 63, wr = wid >> 2, wc = wid & 3, fr = lane & 15, fq = lane >> 4;
    constexpr bool FP8 = MODE == 1; const int K = g.K, nt = FP8 ? K / 128 : K / BK;
    unsigned voffA[2], voffB[2];
#pragma unroll
    for (int i = 0; i < 2; ++i) { int R, C; stage_rc(tid * 16 + i * 8192, R, C); const int Rb = Epi::PERM ? ((R & ~31) + perm32(R & 31)) : R;
        voffA[i] = (unsigned)(R * g.lda + C) * 2u; voffB[i] = (unsigned)(Rb * g.ldb + C) * 2u; }
    const size_t kstep = (size_t)(BK * 2);
    const size_t hstepA = (size_t)HALF * g.lda * 2, hstepB = (size_t)HALF * g.ldb * 2;
    const size_t tstepA = 2 * hstepA, tstepB = 2 * hstepB;
    const unsigned ldsw = (unsigned)wid * 1024u;
    const int aoff = lds_byte(wr * 64 + fr, fq * 8), boff = lds_byte(wc * 32 + fr, fq * 8);
#define PG8_SA(b, h) (((b) * 2 + (h)) * HTB)
#define PG8_SB(b, h) ((4 + (b) * 2 + (h)) * HTB)
#define PG8_STAGE(bufoff, gbase, voff) do { _Pragma("unroll") for (int _i = 0; _i < 2; ++_i) \
        __builtin_amdgcn_global_load_lds((const unsigned*)((const char*)(gbase) + (voff)[_i]), (LAS unsigned*)(lds + (bufoff) + ldsw + _i * 8192), 16, 0, 0); } while (0)
#define PG8_LD32(p) __builtin_shufflevector(*(const LAS v4i_t*)(p), *(const LAS v4i_t*)((p) + 1024), 0, 1, 2, 3, 4, 5, 6, 7)
#define PG8_LDA0(dst, b, h) do { _Pragma("unroll") for (int m = 0; m < 4; ++m) _Pragma("unroll") for (int k = 0; k < 2; ++k) dst[m][k] = *(const LAS bf16x8*)(lds + PG8_SA(b, h) + aoff + m * 2048 + k * 1024); } while (0)
#define PG8_LDB0(dst, b, h) do { _Pragma("unroll") for (int n = 0; n < 2; ++n) _Pragma("unroll") for (int k = 0; k < 2; ++k) dst[n][k] = *(const LAS bf16x8*)(lds + PG8_SB(b, h) + boff + n * 2048 + k * 1024); } while (0)
#define PG8_LDA1(dst, b, h) do { _Pragma("unroll") for (int m = 0; m < 4; ++m) dst##8[m] = PG8_LD32(lds + PG8_SA(b, h) + aoff + m * 2048); } while (0)
#define PG8_LDB1(dst, b, h) do { _Pragma("unroll") for (int n = 0; n < 2; ++n) dst##8[n] = PG8_LD32(lds + PG8_SB(b, h) + boff + n * 2048); } while (0)
#define PG8_MMA0(ai, bj, At, Bt) do { __builtin_amdgcn_s_setprio(1); _Pragma("unroll") for (int m = 0; m < 4; ++m) _Pragma("unroll") for (int n = 0; n < 2; ++n) _Pragma("unroll") for (int k = 0; k < 2; ++k) \
        acc[ai][bj][m][n] = __builtin_amdgcn_mfma_f32_16x16x32_bf16(Bt[n][k], At[m][k], acc[ai][bj][m][n], 0, 0, 0); __builtin_amdgcn_s_setprio(0); } while (0)
#define PG8_MMA1(ai, bj, At, Bt) do { __builtin_amdgcn_s_setprio(1); _Pragma("unroll") for (int m = 0; m < 4; ++m) _Pragma("unroll") for (int n = 0; n < 2; ++n) \
        asm volatile("v_mfma_f32_16x16x128_f8f6f4 %0, %1, %2, %0" : "+v"(acc[ai][bj][m][n]) : "v"(Bt##8[n]), "v"(At##8[m])); __builtin_amdgcn_s_setprio(0); } while (0)
#define PG8_MMA1S(ai, bj, At, Bt) do { __builtin_amdgcn_s_setprio(1); _Pragma("unroll") for (int m = 0; m < 4; ++m) _Pragma("unroll") for (int n = 0; n < 2; ++n) \
        asm volatile("v_mfma_scale_f32_16x16x128_f8f6f4 %0, %1, %2, %0, %3, %4 op_sel_hi:[0,0,0]" : "+v"(acc[ai][bj][m][n]) : "v"(Bt##8[n]), "v"(At##8[m]), "v"(sclw), "v"(scla)); __builtin_amdgcn_s_setprio(0); } while (0)
#define PG8_KBODY(LA, LB, MM) { \
            const bool last = (t == nt - 2); \
            const char* a1 = cA + (size_t)(t + 1) * kstep; \
            const char* a2 = last ? nA : cA + (size_t)(t + 2) * kstep; const char* b2 = last ? nB : cB + (size_t)(t + 2) * kstep; \
            const char* a3 = a2 + kstep; const char* b3 = b2 + kstep; \
            LB(B0, 0, 0); LB(B1, 0, 1); PG8_SCHED; LA(At, 0, 0); PG8_STAGE(PG8_SA(1, 1), a1 + hstepA, voffA); \
            PG8_WAIT_V(8); PG8_WAIT_L(0); PG8_BAR; MM(0, 0, At, B0); MM(0, 1, At, B1); PG8_BAR; PG8_SCHED; \
            LA(At, 0, 1); PG8_STAGE(PG8_SB(0, 0), b2, voffB); PG8_STAGE(PG8_SB(0, 1), b2 + hstepB, voffB); PG8_STAGE(PG8_SA(0, 0), a2, voffA); \
            PG8_WAIT_V(8); PG8_WAIT_L(0); PG8_BAR; MM(1, 0, At, B0); MM(1, 1, At, B1); PG8_BAR; PG8_SCHED; \
            LB(B0, 1, 0); LB(B1, 1, 1); PG8_SCHED; LA(At, 1, 0); PG8_STAGE(PG8_SA(0, 1), a2 + hstepA, voffA); \
            PG8_WAIT_V(8); PG8_WAIT_L(0); PG8_BAR; MM(0, 0, At, B0); MM(0, 1, At, B1); PG8_BAR; PG8_SCHED; \
            LA(At, 1, 1); PG8_STAGE(PG8_SB(1, 0), b3, voffB); PG8_STAGE(PG8_SB(1, 1), b3 + hstepB, voffB); PG8_STAGE(PG8_SA(1, 0), a3, voffA); \
            PG8_WAIT_V(8); PG8_WAIT_L(0); PG8_BAR; MM(1, 0, At, B0); MM(1, 1, At, B1); PG8_BAR; PG8_SCHED; }
#define PG8_WAIT_V(n) asm volatile("s_waitcnt vmcnt(" #n ")" ::: "memory")
#define PG8_WAIT_L(n) asm volatile("s_waitcnt lgkmcnt(" #n ")" ::: "memory")
#define PG8_BAR __builtin_amdgcn_s_barrier()
#define PG8_SCHED __builtin_amdgcn_sched_barrier(0)
    Unit cur, nxt; int ui = 0;
    if (!S.next(0, cur)) return;
    f32x4 acc[2][2][4][2];
#pragma unroll
    for (int a = 0; a < 2; ++a)
#pragma unroll
        for (int b = 0; b < 2; ++b)
#pragma unroll
            for (int m = 0; m < 4; ++m)
#pragma unroll
                for (int n = 0; n < 2; ++n) acc[a][b][m][n] = (f32x4){0.f, 0.f, 0.f, 0.f};
    int sclw = 119, scla = 124; asm volatile("" : "+v"(sclw), "+v"(scla));
    bf16x8 At[4][2], B0[2][2], B1[2][2]; v8i_t At8[4], B08[2], B18[2];
    const char* cA = (const char*)g.A + (size_t)cur.pm * tstepA; const char* cB = (const char*)g.Bt + (size_t)cur.pn * tstepB;
    PG8_STAGE(PG8_SB(0, 0), cB, voffB); PG8_STAGE(PG8_SB(0, 1), cB + hstepB, voffB); PG8_STAGE(PG8_SA(0, 0), cA, voffA); PG8_STAGE(PG8_SA(0, 1), cA + hstepA, voffA);
    if (wr == 1) PG8_BAR;
    PG8_WAIT_V(2); PG8_BAR;
    PG8_STAGE(PG8_SB(1, 0), cB + kstep, voffB); PG8_STAGE(PG8_SA(1, 0), cA + kstep, voffA); PG8_STAGE(PG8_SB(1, 1), cB + hstepB + kstep, voffB);
    PG8_WAIT_V(6); PG8_BAR;
    for (;;) {
        const bool has_next = S.next(ui + 1, nxt);
        const char* nA = has_next ? (const char*)g.A + (size_t)nxt.pm * tstepA : cA; const char* nB = has_next ? (const char*)g.Bt + (size_t)nxt.pn * tstepB : cB;
        if constexpr (MODE == 2) {
            int t = 0;
            for (; t < g.nt8; t += 2) PG8_KBODY(PG8_LDA1, PG8_LDB1, PG8_MMA1S)
            for (; t < nt; t += 2) PG8_KBODY(PG8_LDA0, PG8_LDB0, PG8_MMA0)
        } else if constexpr (MODE == 1) {
            for (int t = 0; t < nt; t += 2) PG8_KBODY(PG8_LDA1, PG8_LDB1, PG8_MMA1)
        } else {
            for (int t = 0; t < nt; t += 2) PG8_KBODY(PG8_LDA0, PG8_LDB0, PG8_MMA0)
        }
        if (wr == 0) PG8_BAR;
        if constexpr (MODE == 2) asm volatile("s_nop 15\n\ts_nop 15\n\ts_nop 15" ::: "memory");
        if constexpr (FP8) {
            asm volatile("s_nop 15\n\ts_nop 15\n\ts_nop 15" ::: "memory");
#pragma unroll
            for (int a = 0; a < 2; ++a)
#pragma unroll
                for (int b = 0; b < 2; ++b)
#pragma unroll
                    for (int m = 0; m < 4; ++m)
#pragma unroll
                        for (int n = 0; n < 2; ++n) acc[a][b][m][n] *= (1.0f / 256.0f); }
        { int lane_o = lane; asm volatile("" : "+v"(lane_o)); E(acc, cur, wr, wc, lane_o & 15, lane_o >> 4); }
        if (!has_next) break;
#pragma unroll
        for (int a = 0; a < 2; ++a)
#pragma unroll
            for (int b = 0; b < 2; ++b)
#pragma unroll
                for (int m = 0; m < 4; ++m)
#pragma unroll
                    for (int n = 0; n < 2; ++n) acc[a][b][m][n] = (f32x4){0.f, 0.f, 0.f, 0.f};
        cur = nxt; cA = nA; cB = nB; ++ui;
        if (wr == 1) PG8_BAR;
    }
    PG8_WAIT_V(0);
    PG8_BAR;
#undef PG8_SA
#undef PG8_SB
#undef PG8_STAGE
#undef PG8_LDA0
#undef PG8_LDA1
#undef PG8_LDB0
#undef PG8_LDB1
#undef PG8_MMA0
#undef PG8_MMA1
#undef PG8_MMA1S
#undef PG8_KBODY
#undef PG8_LD32
#undef PG8_WAIT_V
#undef PG8_WAIT_L
#undef PG8_BAR
#undef PG8_SCHED
}
}

constexpr size_t MiB = 1u << 20;
constexpr size_t WS_CTL = 0, CTL_ZERO_BYTES = 1 * MiB;
constexpr size_t WS_MOD = 1 * MiB;
constexpr size_t WS_SSMP = 2 * MiB;
constexpr size_t SSMP_A1 = 0, SSMP_A32 = 131072, SSMP_BB = 262144;
constexpr size_t WS_ROPE = 5 * MiB;
constexpr size_t WS_YE = 6 * MiB;
constexpr size_t WS_PP = 8 * MiB;
constexpr size_t WS_UCTX = 12 * MiB;
constexpr size_t WS_BT0 = 14 * MiB;
constexpr size_t WS_WGT = WS_BT0 + 72 * MiB;
constexpr size_t WS_WO0 = WS_WGT + 8 * MiB;
constexpr size_t WS_BT1 = WS_WO0 + 32 * MiB;
constexpr size_t WS_WO1 = WS_BT1 + 128 * MiB;
constexpr size_t WS_PT = WS_WO1 + 32 * MiB;
constexpr size_t WS_KMT = WS_PT + 32 * MiB;
constexpr size_t WS_XN = WS_KMT + 96 * MiB;
constexpr size_t WS_Q = WS_XN + 132 * MiB;
constexpr size_t WS_K = WS_Q + 64 * MiB;
constexpr size_t WS_V = WS_K + 17 * MiB;
constexpr size_t WS_GA = WS_V + 17 * MiB;
constexpr size_t WS_GS = WS_GA + 64 * MiB;
constexpr size_t WS_M1 = WS_GA;
constexpr size_t WS_AS = WS_GS + 64 * MiB;
constexpr size_t WS_YG = WS_AS + 96 * MiB;
constexpr size_t WS_MIX = WS_YG + 64 * MiB;
constexpr size_t WS_D0 = WS_AS;
constexpr size_t WS_S = WS_MIX;
constexpr size_t WS_END = WS_MIX + 128 * MiB;
constexpr int CW_TMO = 0, CW_QCTR = 64, CW_BAR = 4096;

constexpr int RING_BYTES = 131072, TRSCR_BYTES = 8 * 16640  , EPI_OFF = TRSCR_BYTES, LDSCTL_OFF = EPI_OFF + 8192, LDS_BYTES = 147456;
static_assert(LDSCTL_OFF + 512 <= LDS_BYTES, "LDS map");

#define XB_TMO      128
#define XB_XCNT(j)  (256  + 64 * (j))
#define XB_XSUB(j)  (1280 + 64 * (j))
#define XB_XGEN(j)  (2304 + 64 * (j))
#define XB_TOP      3328
#define XB_TOPGEN   3392
#define XCD_BAR_WORDS 3456
#define XB_SPIN_CAP (1u << 18)
__device__ __forceinline__ unsigned xb_ld(unsigned* p)              { return __hip_atomic_load(p, __ATOMIC_RELAXED, __HIP_MEMORY_SCOPE_AGENT); }
__device__ __forceinline__ unsigned xb_add(unsigned* p, unsigned v) { return __hip_atomic_fetch_add(p, v, __ATOMIC_RELAXED, __HIP_MEMORY_SCOPE_AGENT); }
__device__ __forceinline__ unsigned xb_xcc_id() { return (unsigned)__builtin_amdgcn_s_getreg((3 << 11) | 20) & 0xFu; }
#define XB_SPIN(cond, bar) do { unsigned _sp = 0; while (cond) { __builtin_amdgcn_s_sleep(1); \
    if ((++_sp & 255u) == 0u) { if (xb_ld(&(bar)[XB_TMO])) break; if (_sp > XB_SPIN_CAP) { atomicAdd(&(bar)[XB_TMO], 1u); break; } } } } while (0)
struct XcdBarrier { unsigned* bar; unsigned x; volatile LAS unsigned* st; };
__device__ __forceinline__ XcdBarrier xcd_barrier_post(unsigned* bar, volatile LAS unsigned* st) {
    XcdBarrier b; b.bar = bar; b.x = xb_xcc_id(); b.st = st;
    if (threadIdx.x == 0) (void)xb_add(&bar[XB_XCNT(b.x)], 1u);
    return b;
}
__device__ __forceinline__ void xcd_barrier_complete(unsigned* bar, unsigned x, unsigned& nloc, unsigned& nx) {
    const unsigned G = gridDim.x * gridDim.y * gridDim.z;
    unsigned sum, cnt, mine, sp = 0u;
    for (;;) {
        sum = 0u; cnt = 0u; mine = 0u;
#pragma unroll
        for (unsigned j = 0; j < 16; ++j) { const unsigned c = xb_ld(&bar[XB_XCNT(j)]); sum += c; cnt += (c > 0u) ? 1u : 0u; mine = (j == x) ? c : mine; }
        if (sum == G) break;
        __builtin_amdgcn_s_sleep(1);
        if ((++sp & 255u) == 0u) { if (xb_ld(&bar[XB_TMO])) break; if (sp > XB_SPIN_CAP) { atomicAdd(&bar[XB_TMO], 1u); break; } }
    }
    nloc = mine > 0u ? mine : 1u; nx = cnt > 0u ? cnt : 1u;
}
__device__ __forceinline__ void xcd_barrier(const XcdBarrier& b) {
    asm volatile("s_waitcnt vmcnt(0)" ::: "memory");
    __syncthreads();
    if (threadIdx.x == 0) {
        unsigned* bar = b.bar;
        __builtin_amdgcn_s_waitcnt(0);
        unsigned nloc = b.st[0], nx = b.st[1];
        if (nloc == 0u) { xcd_barrier_complete(bar, b.x, nloc, nx); b.st[0] = nloc; b.st[1] = nx; }
        const unsigned old = xb_add(&bar[XB_XSUB(b.x)], 1u);
        const unsigned gen = old / nloc;
        if (old + 1u == (gen + 1u) * nloc) {
            __builtin_amdgcn_fence(__ATOMIC_RELEASE, "agent");
            asm volatile("s_waitcnt vmcnt(0)" ::: "memory");
            const unsigned og = xb_add(&bar[XB_TOP], 1u);
            const unsigned tg = og / nx;
            if (og + 1u == (tg + 1u) * nx) xb_add(&bar[XB_TOPGEN], 1u);
            else XB_SPIN(xb_ld(&bar[XB_TOPGEN]) == tg, bar);
            __builtin_amdgcn_fence(__ATOMIC_ACQUIRE, "agent");
            xb_add(&bar[XB_XGEN(b.x)], 1u);
            asm volatile("s_waitcnt vmcnt(0)" ::: "memory");
        } else {
            XB_SPIN(xb_ld(&bar[XB_XGEN(b.x)]) == gen, bar);
            __builtin_amdgcn_fence(__ATOMIC_ACQUIRE, "agent");
            asm volatile("s_waitcnt vmcnt(0)" ::: "memory");
        }
    }
    __syncthreads();
}

struct Args {
    const float* in[35];
    float* out; unsigned char* ws;
    int ph_lo, ph_hi;
};

__host__ __device__ __forceinline__ int vt_pos(int k) { const int blk = k >> 5, k5 = k & 31, hi = (k5 >> 2) & 1, r = (k5 & 3) + 4 * (k5 >> 3); return 32 * hi + r + 16 * blk; }
__device__ __forceinline__ u32x4 pack8(const f32x4 a, const f32x4 b) { u32x4 w; w.x = cvt_pk_bf16(a[0], a[1]); w.y = cvt_pk_bf16(a[2], a[3]); w.z = cvt_pk_bf16(b[0], b[1]); w.w = cvt_pk_bf16(b[2], b[3]); return w; }

struct EpiIn0 {
    static constexpr bool PERM = true;
    bf16_t *Q, *K, *V, *GA, *GS, *AS, *UC; const float *qw, *kw, *ropec, *ropes; LAS float* P; unsigned char *Q8, *K8, *V8T;
    __device__ __forceinline__ void operator()(const f32x4 (&acc)[2][2][4][2], const pg8::Unit& u, int wr, int wc, int fr, int fq) const {
        const int pn = u.pn, pm = u.pm; const bool ctx = pm >= 64;
        const int cb = 32 * wc + 8 * fq;
        if (pn < 10) {
            const bool isq = pn < 8;
#pragma unroll
            for (int ai = 0; ai < 2; ++ai)
#pragma unroll
                for (int m = 0; m < 4; ++m)
#pragma unroll
                    for (int bj = 0; bj < 2; ++bj) { const f32x4 a = acc[ai][bj][m][0], b = acc[ai][bj][m][1];
                        float s = (a[0] * a[0] + a[1] * a[1]) + (a[2] * a[2] + a[3] * a[3]) + (b[0] * b[0] + b[1] * b[1]) + (b[2] * b[2] + b[3] * b[3]);
                        s += __shfl_xor(s, 16); s += __shfl_xor(s, 32);
                        if (fq == 0) P[(ai * 128 + wr * 64 + m * 16 + fr) * 8 + bj * 4 + wc] = s; }
            LDS_WAIT(); __builtin_amdgcn_s_barrier(); asm volatile("" ::: "memory");
            const float* nw = isq ? qw : kw; const int axis = wc >> 1, fbase = (wc & 1) * 16 + 4 * fq, dbase = axis * 64 + fbase;
            const f32x4 w0 = *(const f32x4*)(nw + dbase), w1 = *(const f32x4*)(nw + dbase + 32);
#pragma unroll
            for (int ai = 0; ai < 2; ++ai)
#pragma unroll
                for (int m = 0; m < 4; ++m) { const int rl = ai * 128 + wr * 64 + m * 16 + fr, row = pm * 256 + rl, t = row & (SEQ - 1), b = row >> 13;
                    f32x4 c4 = (f32x4){1.f, 1.f, 1.f, 1.f}, s4 = (f32x4){0.f, 0.f, 0.f, 0.f};
                    if (!ctx) { const int pos = axis ? (t & 63) : (t >> 6); c4 = *(const f32x4*)(ropec + pos * 32 + fbase); s4 = *(const f32x4*)(ropes + pos * 32 + fbase); }
                    bf16_t* dst;
                    unsigned char* dst8;
                    if (isq) { dst = Q + (size_t)row * 2048 + pn * 256 + cb; dst8 = Q8 + (size_t)row * 2048 + pn * 256 + cb; }
                    else { const size_t krow = ctx ? (size_t)(pm - 64) * SKV + rl : (size_t)b * SKV + CTXL + t; dst = K + krow * 512 + (pn - 8) * 256 + cb; dst8 = K8 + krow * 512 + (pn - 8) * 256 + cb; }
#pragma unroll
                    for (int bj = 0; bj < 2; ++bj) { const f32x4 ps = *(const LAS f32x4*)(P + rl * 8 + bj * 4);
                        const float rstd = __builtin_amdgcn_rsqf(((ps[0] + ps[1]) + (ps[2] + ps[3])) * (1.0f / 128.0f) + EPS);
                        const f32x4 x1 = acc[ai][bj][m][0] * rstd * w0, x2 = acc[ai][bj][m][1] * rstd * w1;
                        const f32x4 o1 = x1 * c4 - x2 * s4, o2 = x2 * c4 + x1 * s4;
                        if (ATT_PROBE) *(u32x4*)(dst + bj * 128) = pack8(o1, o2);
                        { u32x2 w8; const float qs = isq ? QK_LOG2_SCALE : 1.0f; const f32x4 e1 = o1 * qs, e2 = o2 * qs;
                          int tq = __builtin_amdgcn_cvt_pk_fp8_f32(e1[0], e1[1], 0, false); tq = __builtin_amdgcn_cvt_pk_fp8_f32(e1[2], e1[3], tq, true); w8.x = (unsigned)tq;
                          tq = __builtin_amdgcn_cvt_pk_fp8_f32(e2[0], e2[1], 0, false); tq = __builtin_amdgcn_cvt_pk_fp8_f32(e2[2], e2[3], tq, true); w8.y = (unsigned)tq;
                          *(u32x2*)(dst8 + bj * 128) = w8; } } }
            return;
        }
        const int mode = pn < 12 ? 0 : (pn < 20 ? 1 : (pn < 28 ? 2 : 3));
#pragma unroll
        for (int ai = 0; ai < 2; ++ai)
#pragma unroll
            for (int m = 0; m < 4; ++m) { const int rl = ai * 128 + wr * 64 + m * 16 + fr, row = pm * 256 + rl, t = row & (SEQ - 1), b = row >> 13;
#pragma unroll
                for (int bj = 0; bj < 2; ++bj) { f32x4 a = acc[ai][bj][m][0], c = acc[ai][bj][m][1]; bf16_t* dst;
                    if (mode == 0) { const int kk = ctx ? rl : CTXL + t, bb = ctx ? pm - 64 : b, vcol = (pn - 10) * 256 + bj * 128 + cb;
                        unsigned char* vt = V8T + ((size_t)(bb * 4 + (vcol >> 7)) * 128 + (vcol & 127)) * SKV + (kk & ~63) + vt_pos(kk & 63);
                        const int w0 = __builtin_amdgcn_cvt_pk_fp8_f32(a[0], a[1], 0, false), w1 = __builtin_amdgcn_cvt_pk_fp8_f32(a[2], a[3], 0, false);
                        const int w2 = __builtin_amdgcn_cvt_pk_fp8_f32(c[0], c[1], 0, false), w3 = __builtin_amdgcn_cvt_pk_fp8_f32(c[2], c[3], 0, false);
                        vt[0] = (unsigned char)w0; vt[SKV] = (unsigned char)(w0 >> 8); vt[2 * SKV] = (unsigned char)w1; vt[3 * SKV] = (unsigned char)(w1 >> 8);
                        vt[4 * SKV] = (unsigned char)w2; vt[5 * SKV] = (unsigned char)(w2 >> 8); vt[6 * SKV] = (unsigned char)w3; vt[7 * SKV] = (unsigned char)(w3 >> 8);
                        if (!ATT_PROBE) continue;
                        const size_t krow = ctx ? (size_t)(pm - 64) * SKV + rl : (size_t)b * SKV + CTXL + t; dst = V + krow * 512 + (pn - 10) * 256 + bj * 128 + cb; }
                    else if (mode == 2) { const int gcol = (pn - 20) * 256 + bj * 128 + cb, g = gcol >> 4, j0 = gcol & 15;
                        dst = ctx ? UC + ((size_t)((pm - 64) * NGRP + g) * CTXL + rl) * 16 + j0 : AS + ((size_t)((b * NGRP + g) * NCHUNK) + (t >> 5)) * 768 + (t & 31) * 16 + j0; }
                    else { bf16_t* base = mode == 1 ? GA : GS; const int c0 = (mode == 1 ? pn - 12 : pn - 28) * 256 + bj * 128 + cb; dst = base + (size_t)row * 2048 + c0;
#pragma unroll
                        for (int e = 0; e < 4; ++e) { a[e] = siluf_(a[e]); c[e] = siluf_(c[e]); } }
                    *(u32x4*)dst = pack8(a, c); } }
    }
};
struct EpiS {
    static constexpr bool PERM = true;
    float* S;
    __device__ __forceinline__ void operator()(const f32x4 (&acc)[2][2][4][2], const pg8::Unit& u, int wr, int wc, int fr, int fq) const {
#pragma unroll
        for (int ai = 0; ai < 2; ++ai)
#pragma unroll
            for (int m = 0; m < 4; ++m) { float* rp = S + ((size_t)u.pm * 256 + ai * 128 + wr * 64 + m * 16 + fr) * 256 + wc * 32 + 8 * fq;
#pragma unroll
                for (int bj = 0; bj < 2; ++bj)
#pragma unroll
                    for (int n = 0; n < 2; ++n) *(f32x4*)(rp + bj * 128 + n * 4) = acc[ai][bj][m][n]; }
    }
};
struct EpiY {
    static constexpr bool PERM = true;
    bf16_t* YG; unsigned char* YG8;
    __device__ __forceinline__ void operator()(const f32x4 (&acc)[2][2][4][2], const pg8::Unit& u, int wr, int wc, int fr, int fq) const {
        const int b = u.pm >> 7, g = u.pm & 127, half = u.pn & 1;
#pragma unroll
        for (int ai = 0; ai < 2; ++ai)
#pragma unroll
            for (int m = 0; m < 4; ++m) { const int ch = ai * 128 + wr * 64 + m * 16 + fr;
#pragma unroll
                for (int bj = 0; bj < 2; ++bj) { const int ncol = half * 256 + bj * 128 + wc * 32 + 8 * fq, tau = ncol >> 4, i0 = ncol & 15;
                    f32x4 a = acc[ai][bj][m][0], c = acc[ai][bj][m][1];
#pragma unroll
                    for (int e = 0; e < 4; ++e) { a[e] = gelu_tanh_(a[e]); c[e] = gelu_tanh_(c[e]); }
                    const size_t yo = ((size_t)b * SEQ + ch * 32 + tau) * 2048 + g * 16 + i0;
                    *(u32x4*)(YG + yo) = pack8(a, c);
                    { u32x2 w8; a = a * 8.f; c = c * 8.f;
#pragma unroll
                      for (int e = 0; e < 4; ++e) { a[e] = __builtin_fminf(__builtin_fmaxf(a[e], -448.f), 448.f); c[e] = __builtin_fminf(__builtin_fmaxf(c[e], -448.f), 448.f); }
                      int t = __builtin_amdgcn_cvt_pk_fp8_f32(a[0], a[1], 0, false); t = __builtin_amdgcn_cvt_pk_fp8_f32(a[2], a[3], t, true); w8.x = (unsigned)t;
                      t = __builtin_amdgcn_cvt_pk_fp8_f32(c[0], c[1], 0, false); t = __builtin_amdgcn_cvt_pk_fp8_f32(c[2], c[3], t, true); w8.y = (unsigned)t;
                      *(u32x2*)(YG8 + yo) = w8; } } }
    }
};
struct EpiGlu {
    static constexpr bool PERM = true;
    const bf16_t *YG, *GS; const float* bglu; bf16_t* MIX;
    __device__ __forceinline__ void operator()(const f32x4 (&acc)[2][2][4][2], const pg8::Unit& u, int wr, int wc, int fr, int fq) const {
#pragma unroll
        for (int bj = 0; bj < 2; ++bj) { const int col = u.pn * 256 + bj * 128 + wc * 32 + 8 * fq;
            const f32x4 b0 = *(const f32x4*)(bglu + col), b1 = *(const f32x4*)(bglu + col + 4);
#pragma unroll
            for (int ai = 0; ai < 2; ++ai)
#pragma unroll
                for (int m = 0; m < 4; ++m) { const size_t row = (size_t)u.pm * 256 + ai * 128 + wr * 64 + m * 16 + fr;
                    const u32x4 y = *(const u32x4*)(YG + row * 2048 + col), gs = *(const u32x4*)(GS + row * 2048 + col);
                    const f32x4 a = acc[ai][bj][m][0] + b0, c = acc[ai][bj][m][1] + b1; f32x4 o0, o1;
                    o0[0] = bf_lo(y.x) * sigmoidf_(a[0]) * bf_lo(gs.x); o0[1] = bf_hi(y.x) * sigmoidf_(a[1]) * bf_hi(gs.x);
                    o0[2] = bf_lo(y.y) * sigmoidf_(a[2]) * bf_lo(gs.y); o0[3] = bf_hi(y.y) * sigmoidf_(a[3]) * bf_hi(gs.y);
                    o1[0] = bf_lo(y.z) * sigmoidf_(c[0]) * bf_lo(gs.z); o1[1] = bf_hi(y.z) * sigmoidf_(c[1]) * bf_hi(gs.z);
                    o1[2] = bf_lo(y.w) * sigmoidf_(c[2]) * bf_lo(gs.w); o1[3] = bf_hi(y.w) * sigmoidf_(c[3]) * bf_hi(gs.w);
                    *(u32x4*)((unsigned char*)MIX + row * 6144 + 2048 + (size_t)col * 2) = pack8(o0, o1); } }
    }
};
struct EpiDelta {
    static constexpr bool PERM = true;
    bf16_t* D0; const float* gate;
    __device__ __forceinline__ void operator()(const f32x4 (&acc)[2][2][4][2], const pg8::Unit& u, int wr, int wc, int fr, int fq) const {
        const int b = u.pm >> 5;
#pragma unroll
        for (int bj = 0; bj < 2; ++bj) { const int col = u.pn * 256 + bj * 128 + wc * 32 + 8 * fq;
            const f32x4 g0 = *(const f32x4*)(gate + b * 12288 + col), g1 = *(const f32x4*)(gate + b * 12288 + col + 4);
#pragma unroll
            for (int ai = 0; ai < 2; ++ai)
#pragma unroll
                for (int m = 0; m < 4; ++m) { const size_t off = ((size_t)u.pm * 256 + ai * 128 + wr * 64 + m * 16 + fr) * 4096 + col;
                    *(u32x4*)(D0 + off) = pack8(g0 * acc[ai][bj][m][0], g1 * acc[ai][bj][m][1]); } }
    }
};
struct EpiOut {
    static constexpr bool PERM = true;
    const float* x; const bf16_t* D0; float* out; const float* gate;
    __device__ __forceinline__ void operator()(const f32x4 (&acc)[2][2][4][2], const pg8::Unit& u, int wr, int wc, int fr, int fq) const {
        const int b = u.pm >> 5;
#pragma unroll
        for (int bj = 0; bj < 2; ++bj) { const int col = u.pn * 256 + bj * 128 + wc * 32 + 8 * fq;
            const f32x4 g0 = *(const f32x4*)(gate + b * 12288 + col), g1 = *(const f32x4*)(gate + b * 12288 + col + 4);
#pragma unroll
            for (int ai = 0; ai < 2; ++ai)
#pragma unroll
                for (int m = 0; m < 4; ++m) { const size_t off = ((size_t)u.pm * 256 + ai * 128 + wr * 64 + m * 16 + fr) * 4096 + col;
                    const f32x4 r0 = *(const f32x4*)(x + off), r1 = *(const f32x4*)(x + off + 4); const u32x4 d = *(const u32x4*)(D0 + off);
                    f32x4 d0, d1; d0[0] = bf_lo(d.x); d0[1] = bf_hi(d.x); d0[2] = bf_lo(d.y); d0[3] = bf_hi(d.y); d1[0] = bf_lo(d.z); d1[1] = bf_hi(d.z); d1[2] = bf_lo(d.w); d1[3] = bf_hi(d.w);
                    *(f32x4*)(out + off) = (r0 + d0) + g0 * acc[ai][bj][m][0]; *(f32x4*)(out + off + 4) = (r1 + d1) + g1 * acc[ai][bj][m][1]; } }
    }
};
#define DPPF(old, src, ctrl) __int_as_float(__builtin_amdgcn_update_dpp(__float_as_int(old), __float_as_int(src), ctrl, 0xF, 0xF, false))
struct EpiConv {
    static constexpr bool PERM = false;
    bf16_t* M1; const float *cw, *cb; float *YE, *PP; LAS float* EB;
    __device__ __forceinline__ void operator()(const f32x4 (&acc)[2][2][4][2], const pg8::Unit& u, int wr, int wc, int fr, int fq) const {
        const int chl = 16 * wc + 4 * fq, ch = u.pn * 64 + chl;
        f32x4 y[2][4], eprev[2], enext[2];
#pragma unroll
        for (int ai = 0; ai < 2; ++ai)
#pragma unroll
            for (int m = 0; m < 4; ++m) y[ai][m] = acc[ai][0][m][1] * acc[ai][1][m][0];
#pragma unroll
        for (int ai = 0; ai < 2; ++ai) { const int run = 2 * ai + wr;
            if (fr == 0) *(LAS f32x4*)(EB + (run * 2 + 0) * 64 + chl) = y[ai][0];
            if (fr == 15) *(LAS f32x4*)(EB + (run * 2 + 1) * 64 + chl) = y[ai][3]; }
        LDS_WAIT(); __builtin_amdgcn_s_barrier(); asm volatile("" ::: "memory");
#pragma unroll
        for (int ai = 0; ai < 2; ++ai) { const int run = 2 * ai + wr;
            eprev[ai] = run > 0 ? *(const LAS f32x4*)(EB + ((run - 1) * 2 + 1) * 64 + chl) : (f32x4){0.f, 0.f, 0.f, 0.f};
            enext[ai] = run < 3 ? *(const LAS f32x4*)(EB + ((run + 1) * 2 + 0) * 64 + chl) : (f32x4){0.f, 0.f, 0.f, 0.f}; }
        const f32x4 w0 = *(const f32x4*)(cw + ch), w1 = *(const f32x4*)(cw + 4096 + ch), w2 = *(const f32x4*)(cw + 8192 + ch), bs = *(const f32x4*)(cb + ch);
#pragma unroll
        for (int ai = 0; ai < 2; ++ai)
#pragma unroll
            for (int m = 0; m < 4; ++m) { f32x4 yp, yn, p, cv;
#pragma unroll
                for (int e = 0; e < 4; ++e) {
                    const float wp = m > 0 ? DPPF(0.f, y[ai][m > 0 ? m - 1 : 0][e], 0x121) : eprev[ai][e];
                    const float wn = m < 3 ? DPPF(0.f, y[ai][m < 3 ? m + 1 : 3][e], 0x12F) : enext[ai][e];
                    yp[e] = DPPF(wp, y[ai][m][e], 0x111); yn[e] = DPPF(wn, y[ai][m][e], 0x101);
                    p[e] = acc[ai][0][m][0][e] * siluf_(acc[ai][1][m][1][e]); }
                cv = bs + w0 * yp + w1 * y[ai][m] + w2 * yn;
                const int rl = ai * 128 + wr * 64 + m * 16 + fr; const size_t row = (size_t)u.pm * 256 + rl;
                const f32x4 o = p * cv; u32x2 w; w.x = cvt_pk_bf16(o[0], o[1]); w.y = cvt_pk_bf16(o[2], o[3]);
                *(u32x2*)(M1 + row * 4096 + ch) = w;
                if (rl == 0 || rl == 255) { const int side = rl ? 1 : 0; const size_t eo = ((size_t)u.pm * 2 + side) * 4096 + ch;
                    *(f32x4*)(YE + eo) = y[ai][m];
                    *(f32x4*)(PP + 2 * eo) = p; *(f32x4*)(PP + 2 * eo + 4) = cv; } }
    }
};

struct CtxOrder {
    int c;
    __device__ bool next(int i, pg8::Unit& u) const {
        if (i != 0 || c >= 24) return false;
        u.pm = 64 + c / 12; const int j = c % 12; u.pn = j < 4 ? 8 + j : 16 + j; return true;
    }
};
struct SsmSOrder { int G, c; __device__ bool next(int i, pg8::Unit& u) const { const int L = i * G + c; if (L >= 256) return false; u.pm = L; u.pn = L & 127; return true; } };
struct SsmYOrder { int G, c;
    __device__ bool next(int i, pg8::Unit& u) const {
        if (G == 256) { if (i >= 2) return false; u.pm = c; u.pn = (c & 127) * 2 + i; return true; }
        const int L = i * G + c; if (L >= 512) return false; u.pm = L >> 1; u.pn = ((L >> 1) & 127) * 2 + (L & 1); return true; } };

namespace att {
using bf16 = __hip_bfloat16;
constexpr int D = 128, NW = 8, QBLK = 32, KVBLK = 64, LDQ = 2048, LDK = 512;
constexpr float SCALE = 0.088388347648318440f, THR = 8.f;
using s16x4  = __attribute__((ext_vector_type(4))) short;
using f32x16 = __attribute__((ext_vector_type(16))) float;
constexpr size_t SHM_V = KVBLK * D * 2, SHM_K = KVBLK * D * 2, SHM_ATTN = 2 * SHM_V + 2 * SHM_K + NW * 64 * 4;
#define KSWZ(row, colB) ((row) * 256 + ((colB) ^ (((row) & 7) << 4)))
#define SBAR() __builtin_amdgcn_sched_barrier(0)
__device__ __forceinline__ int crow(int r, int hi) { return (r & 3) + 8 * (r >> 2) + 4 * hi; }
template <bool FIX>
__device__ __forceinline__ void partialSM(f32x16& p0, f32x16& p1, float& m_reg, float& mn, float& alpha, float mfixC) {
  constexpr float C = SCALE * 1.4426950408889634f;
  float mnC;
  if constexpr (FIX) { alpha = 1.f; mn = 0.f; mnC = -mfixC; }
  else {
  float pmax = p0[0]; for (int r = 1; r < 16; ++r) pmax = fmaxf(pmax, p0[r]); for (int r = 0; r < 16; ++r) pmax = fmaxf(pmax, p1[r]);
  { auto rr = __builtin_amdgcn_permlane32_swap(__float_as_uint(pmax), __float_as_uint(pmax), false, false);
    pmax = fmaxf(__uint_as_float(rr[0]), __uint_as_float(rr[1])); }
  if (__builtin_expect(__all(pmax - m_reg <= THR / SCALE), 1)) { mn = m_reg; alpha = 1.f; }
  else { mn = fmaxf(m_reg, pmax); alpha = __builtin_amdgcn_exp2f((m_reg - mn) * C); m_reg = mn; }
  mnC = -mn * C; }
  for (int r = 0; r < 16; ++r) p0[r] = fmaf(p0[r], C, mnC); for (int r = 0; r < 16; ++r) p1[r] = fmaf(p1[r], C, mnC);
  for (int r = 0; r < 16; ++r) p0[r] = __builtin_amdgcn_exp2f(p0[r]);
}
__device__ __forceinline__ void finishSM(f32x16& p0, f32x16& p1, float alpha, float& l_reg, bf16x8& pa0, bf16x8& pa1, bf16x8& pa2, bf16x8& pa3) {
  for (int r = 0; r < 16; ++r) p1[r] = __builtin_amdgcn_exp2f(p1[r]);
  float ps = 0; for (int r = 0; r < 16; ++r) ps += p0[r]; for (int r = 0; r < 16; ++r) ps += p1[r];
  { auto rr = __builtin_amdgcn_permlane32_swap(__float_as_uint(ps), __float_as_uint(ps), false, false);
    ps = __uint_as_float(rr[0]) + __uint_as_float(rr[1]); }
  l_reg = l_reg * alpha + ps;
#define PK4(P, BASE, OUT) do { unsigned a0 = cvt_pk_bf16(P[BASE + 0], P[BASE + 1]), a1 = cvt_pk_bf16(P[BASE + 2], P[BASE + 3]);   \
    unsigned b0 = cvt_pk_bf16(P[BASE + 4], P[BASE + 5]), b1 = cvt_pk_bf16(P[BASE + 6], P[BASE + 7]);                              \
    auto r0 = __builtin_amdgcn_permlane32_swap(a0, b0, false, false); auto r1 = __builtin_amdgcn_permlane32_swap(a1, b1, false, false); \
    u32x4 w = {r0[0], r1[0], r0[1], r1[1]}; OUT = *reinterpret_cast<bf16x8*>(&w); } while (0)
  PK4(p0, 0, pa0); PK4(p0, 8, pa1); PK4(p1, 0, pa2); PK4(p1, 8, pa3);
#undef PK4
}
__device__ __forceinline__ void qkt(f32x16& p0, f32x16& p1, const bf16* Ks, const bf16x8* qr, int r32, int hi) {
  p0 = f32x16{}; p1 = f32x16{};
  for (int d0 = 0; d0 < 8; ++d0) { int cb = (d0 * 16 + hi * 8) * 2;
    bf16x8 b0 = *reinterpret_cast<const bf16x8*>((const char*)Ks + KSWZ(r32, cb));
    bf16x8 b1 = *reinterpret_cast<const bf16x8*>((const char*)Ks + KSWZ(32 + r32, cb));
    p0 = __builtin_amdgcn_mfma_f32_32x32x16_bf16(b0, qr[d0], p0, 0, 0, 0);
    p1 = __builtin_amdgcn_mfma_f32_32x32x16_bf16(b1, qr[d0], p1, 0, 0, 0); }
}
__device__ __forceinline__ int v_st(int k, int c) { const int kk = (k & ~0xC) | ((k & 4) << 1) | ((k & 8) >> 1); return ((kk >> 3) * 4 + (c >> 5)) * 512 + ((kk & 7) * 32 + (c & 31)) * 2; }
__device__ __forceinline__ int v_rd_base(int lane) { return ((lane & 3) << 3) | (((lane >> 2) & 3) << 6) | (((lane >> 4) & 1) << 5) | (((lane >> 5) & 1) << 8); }
constexpr int v_rd_off(int d0, int ks, int half) { return d0 * 512 + ks * 4096 + half * 2048; }
template <int OFF> __device__ __forceinline__ s16x4 tr_read(int vb) {
  s16x4 r; asm volatile("ds_read_b64_tr_b16 %0, %1 offset:%2" : "=&v"(r) : "v"(vb), "i"(OFF) : "memory"); return r;
}
template <int D0> __device__ __forceinline__ void pv_one(f32x16& od, int vb, bf16x8 pa0, bf16x8 pa1, bf16x8 pa2, bf16x8 pa3) {
  const s16x4 l0 = tr_read<v_rd_off(D0, 0, 0)>(vb), h0 = tr_read<v_rd_off(D0, 0, 1)>(vb), l1 = tr_read<v_rd_off(D0, 1, 0)>(vb), h1 = tr_read<v_rd_off(D0, 1, 1)>(vb);
  const s16x4 l2 = tr_read<v_rd_off(D0, 2, 0)>(vb), h2 = tr_read<v_rd_off(D0, 2, 1)>(vb), l3 = tr_read<v_rd_off(D0, 3, 0)>(vb), h3 = tr_read<v_rd_off(D0, 3, 1)>(vb);
  asm volatile("s_waitcnt lgkmcnt(0)" ::: "memory"); SBAR();
#define PK(L, H) (bf16x8){L[0], L[1], L[2], L[3], H[0], H[1], H[2], H[3]}
  od = __builtin_amdgcn_mfma_f32_32x32x16_bf16(pa0, PK(l0, h0), od, 0, 0, 0);
  od = __builtin_amdgcn_mfma_f32_32x32x16_bf16(pa1, PK(l1, h1), od, 0, 0, 0);
  od = __builtin_amdgcn_mfma_f32_32x32x16_bf16(pa2, PK(l2, h2), od, 0, 0, 0);
  od = __builtin_amdgcn_mfma_f32_32x32x16_bf16(pa3, PK(l3, h3), od, 0, 0, 0);
#undef PK
}
__device__ __forceinline__ void pv_d0(f32x16* o, int vb, bf16x8 pa0, bf16x8 pa1, bf16x8 pa2, bf16x8 pa3) {
  pv_one<0>(o[0], vb, pa0, pa1, pa2, pa3); pv_one<1>(o[1], vb, pa0, pa1, pa2, pa3); pv_one<2>(o[2], vb, pa0, pa1, pa2, pa3); pv_one<3>(o[3], vb, pa0, pa1, pa2, pa3);
}
template <bool FIX>
__device__ __forceinline__ void attn_dense_body(const bf16* __restrict__ Qb, const bf16* __restrict__ Kh, const bf16* __restrict__ Vh,
                                                const bf16_t* __restrict__ Gb, bf16_t* __restrict__ Ob, int seq, char* lds, float mfixC) {
  int tid_o = threadIdx.x; asm volatile("" : "+v"(tid_o));
  const int tid = tid_o, wid = tid >> 6, lane = tid & 63, r32 = lane & 31, hi = lane >> 5;
  bf16* V_lds = (bf16*)lds; bf16* K_lds = (bf16*)(lds + 2 * SHM_V);
  float* ws = (float*)(lds + 2 * SHM_V + 2 * SHM_K) + wid * 64; float* li_l = ws;
  float m_reg = -1e30f, l_reg = 0; f32x16 o[4] = {}; bf16x8 qr[8];
  const bf16* Qw = Qb + (long)(wid * QBLK + r32) * LDQ + hi * 8;
#pragma unroll
  for (int d0 = 0; d0 < 8; ++d0) qr[d0] = *reinterpret_cast<const bf16x8*>(Qw + d0 * 16);
  const int sr = tid >> 4, sc = (tid & 15) * 8, vst0 = v_st(sr, sc), vst1 = v_st(32 + sr, sc);
  const int vb0 = (int)(uintptr_t)V_lds + v_rd_base(lane);
  struct { bf16x8 vs0, vs1, ks0, ks1; } sr_[2];
#define SLOAD(i, k0) do { sr_[i].vs0 = *reinterpret_cast<const bf16x8*>(&Vh[(long)((k0) + sr) * LDK + sc]); sr_[i].vs1 = *reinterpret_cast<const bf16x8*>(&Vh[(long)((k0) + 32 + sr) * LDK + sc]); \
    sr_[i].ks0 = *reinterpret_cast<const bf16x8*>(&Kh[(long)((k0) + sr) * LDK + sc]); sr_[i].ks1 = *reinterpret_cast<const bf16x8*>(&Kh[(long)((k0) + 32 + sr) * LDK + sc]); } while (0)
#define SWRITE(b, i) do { *(bf16x8*)((char*)V_lds + (b) * SHM_V + vst0) = sr_[i].vs0;          \
    *(bf16x8*)((char*)V_lds + (b) * SHM_V + vst1) = sr_[i].vs1; int kc = sc * 2;               \
    *(bf16x8*)((char*)K_lds + (b) * SHM_K + KSWZ(sr, kc)) = sr_[i].ks0;                       \
    *(bf16x8*)((char*)K_lds + (b) * SHM_K + KSWZ(32 + sr, kc)) = sr_[i].ks1; } while (0)
#define SWAIT() asm volatile("s_waitcnt vmcnt(4)" ::: "memory")
#define RESC(a) do { if (__any((a) < 1.f)) { int t3 = threadIdx.x; asm volatile("" : "+v"(t3));     \
    float* al_x = (float*)(lds + 2 * SHM_V + 2 * SHM_K) + (t3 >> 6) * 64 + 32; const int hi3 = (t3 >> 5) & 1; \
    if (hi3 == 0) al_x[t3 & 31] = (a); asm volatile("s_waitcnt lgkmcnt(0)" ::: "memory"); \
    for (int d = 0; d < 4; ++d) for (int r = 0; r < 16; ++r) o[d][r] *= al_x[crow(r, hi3)]; } } while (0)
  f32x16 pA0, pA1, pB0, pB1; float mnA, mnB, alA, alB; bf16x8 pa0, pa1, pa2, pa3; const int NT = seq / KVBLK;
  constexpr int SE = 0, SO = 1;
  SLOAD(SE, 0); asm volatile("s_waitcnt vmcnt(0)" ::: "memory"); SWRITE(0, SE); __syncthreads();
  qkt(pA0, pA1, K_lds, qr, r32, hi); partialSM<FIX>(pA0, pA1, m_reg, mnA, alA, mfixC);
  SLOAD(SO, KVBLK); if (2 < NT) SLOAD(SE, 2 * KVBLK);
  SWAIT(); SWRITE(1, SO); __syncthreads();
  for (int j = 1; j + 1 < NT; j += 2) {
    SBAR(); qkt(pB0, pB1, (bf16*)((char*)K_lds + SHM_K), qr, r32, hi);
    finishSM(pA0, pA1, alA, l_reg, pa0, pa1, pa2, pa3); SBAR();
    SLOAD(SO, (j + 2) * KVBLK); SBAR();
    pv_d0(o, vb0, pa0, pa1, pa2, pa3); partialSM<FIX>(pB0, pB1, m_reg, mnB, alB, mfixC);
    __syncthreads(); SWAIT(); SWRITE(0, SE);
    RESC(alB); __syncthreads();
    SBAR(); qkt(pA0, pA1, K_lds, qr, r32, hi);
    finishSM(pB0, pB1, alB, l_reg, pa0, pa1, pa2, pa3); SBAR();
    if (j + 3 < NT) SLOAD(SE, (j + 3) * KVBLK); SBAR();
    pv_d0(o, vb0 + (int)SHM_V, pa0, pa1, pa2, pa3); partialSM<FIX>(pA0, pA1, m_reg, mnA, alA, mfixC);
    __syncthreads(); SWAIT(); SWRITE(1, SO);
    RESC(alA); __syncthreads();
  }
  SBAR(); qkt(pB0, pB1, (bf16*)((char*)K_lds + SHM_K), qr, r32, hi);
  finishSM(pA0, pA1, alA, l_reg, pa0, pa1, pa2, pa3); SBAR();
  pv_d0(o, vb0, pa0, pa1, pa2, pa3); partialSM<FIX>(pB0, pB1, m_reg, mnB, alB, mfixC);
  __syncthreads(); RESC(alB);
  finishSM(pB0, pB1, alB, l_reg, pa0, pa1, pa2, pa3); SBAR();
  pv_d0(o, vb0 + (int)SHM_V, pa0, pa1, pa2, pa3);
  if (hi == 0) li_l[r32] = l_reg; asm volatile("s_waitcnt lgkmcnt(0)" ::: "memory");
  int tid2 = threadIdx.x; asm volatile("" : "+v"(tid2));
  const int lane_o = tid2 & 63, wid2 = tid2 >> 6, odd = lane_o & 1, ce = (lane_o & 30), hio = lane_o >> 5;
  const bf16_t* Gw = Gb + (long)(wid2 * QBLK) * 2048; bf16_t* Ow = Ob + (long)(wid2 * QBLK) * 4096;
#pragma unroll
  for (int r = 0; r < 16; r += 2) { const int rowa = crow(r, hio), rowme = rowa + odd;
    const float ra = __builtin_amdgcn_rcpf(li_l[rowa]), rb = __builtin_amdgcn_rcpf(li_l[rowa + 1]);
#pragma unroll
    for (int d0 = 0; d0 < 4; ++d0) { const float a = o[d0][r] * ra, b = o[d0][r + 1] * rb;
      const float send = odd ? a : b, recv = __shfl_xor(send, 1);
      const float v0 = odd ? recv : a, v1 = odd ? b : recv;
      const unsigned gw = *(const unsigned*)(Gw + (long)rowme * 2048 + d0 * 32 + ce);
      *(unsigned*)(Ow + (long)rowme * 4096 + d0 * 32 + ce) = cvt_pk_bf16(v0 * bf_lo(gw), v1 * bf_hi(gw)); } }
  __syncthreads();
#undef SLOAD
#undef SWRITE
#undef SWAIT
#undef RESC
}

constexpr size_t SHM_K8 = KVBLK * D;
constexpr size_t SHM_ATTN3 = 3 * SHM_V + 3 * SHM_K8 + NW * 64 * 4;
typedef int v8i_a __attribute__((ext_vector_type(8)));
typedef int v4i_a __attribute__((ext_vector_type(4)));
#define KSWZ8(row, colB) ((row) * 128 + ((colB) ^ (((row) & 7) << 4)))
__device__ __forceinline__ void qkt8(f32x16& p0, f32x16& p1, const char* Ks, const v8i_a (&qf)[2], int r32, int hi, const f32x16& cneg) {
  v8i_a kf[2][2];
#pragma unroll
  for (int kh = 0; kh < 2; ++kh)
#pragma unroll
    for (int t = 0; t < 2; ++t) { const int row = 32 * kh + r32, cb = 64 * t + 32 * hi;
      const v4i_a lo = *reinterpret_cast<const v4i_a*>(Ks + KSWZ8(row, cb)), hi4 = *reinterpret_cast<const v4i_a*>(Ks + KSWZ8(row, cb + 16));
      kf[kh][t] = __builtin_shufflevector(lo, hi4, 0, 1, 2, 3, 4, 5, 6, 7); }
  asm volatile("v_mfma_f32_32x32x64_f8f6f4 %0, %1, %2, %3" : "=&v"(p0) : "v"(kf[0][0]), "v"(qf[0]), "v"(cneg));
  asm volatile("v_mfma_f32_32x32x64_f8f6f4 %0, %1, %2, %3" : "=&v"(p1) : "v"(kf[1][0]), "v"(qf[0]), "v"(cneg));
  asm volatile("v_mfma_f32_32x32x64_f8f6f4 %0, %1, %2, %0" : "+v"(p0) : "v"(kf[0][1]), "v"(qf[1]));
  asm volatile("v_mfma_f32_32x32x64_f8f6f4 %0, %1, %2, %0" : "+v"(p1) : "v"(kf[1][1]), "v"(qf[1]));
}
__device__ __forceinline__ float attn_rowmax(const unsigned char* __restrict__ Qb, const unsigned char* __restrict__ Kh, int seq, char* lds) {
  int tid_o = threadIdx.x; asm volatile("" : "+v"(tid_o));
  const int tid = tid_o, wid = tid >> 6, lane = tid & 63, r32 = lane & 31, hi = lane >> 5;
  char* K_lds = lds; v8i_a qf[2];
  { const unsigned char* Qw = Qb + (long)(wid * QBLK + r32) * 2048 + hi * 32;
#pragma unroll
    for (int t = 0; t < 2; ++t) { const v4i_a lo = *reinterpret_cast<const v4i_a*>(Qw + 64 * t), h4 = *reinterpret_cast<const v4i_a*>(Qw + 64 * t + 16); qf[t] = __builtin_shufflevector(lo, h4, 0, 1, 2, 3, 4, 5, 6, 7); } }
  const int kr = tid >> 3, kcb = (tid & 7) * 16, kst = KSWZ8(kr, kcb); float m = -1e30f; const f32x16 czero = {};
  for (int j = 0; j < seq / KVBLK; ++j) {
    const v4i_a k0 = *reinterpret_cast<const v4i_a*>(Kh + (long)(j * KVBLK + kr) * 512 + kcb);
    __syncthreads();
    *(v4i_a*)(K_lds + kst) = k0;
    __syncthreads();
    f32x16 p0, p1; qkt8(p0, p1, K_lds, qf, r32, hi, czero);
    asm volatile("s_nop 15\n\ts_nop 15\n\ts_nop 15\n\ts_nop 15\n\ts_nop 15" ::: "memory");
    for (int r = 0; r < 16; ++r) m = fmaxf(m, fmaxf(p0[r], p1[r]));
  }
  auto rr = __builtin_amdgcn_permlane32_swap(__float_as_uint(m), __float_as_uint(m), false, false);
  m = fmaxf(__uint_as_float(rr[0]), __uint_as_float(rr[1]));
  __syncthreads();
  return m;
}
constexpr int VT_PITCH = 80;
constexpr size_t SHM_VT = 128 * VT_PITCH;
__device__ __forceinline__ void finishSM8(f32x16& p0, f32x16& p1, float& l_reg, v8i_a& pa) {
  for (int r = 0; r < 16; ++r) p1[r] = __builtin_amdgcn_exp2f(p1[r]);
  float ps = 0; for (int r = 0; r < 16; ++r) ps += p0[r]; for (int r = 0; r < 16; ++r) ps += p1[r];
  { auto rr = __builtin_amdgcn_permlane32_swap(__float_as_uint(ps), __float_as_uint(ps), false, false);
    ps = __uint_as_float(rr[0]) + __uint_as_float(rr[1]); }
  l_reg += ps;
#pragma unroll
  for (int q = 0; q < 4; ++q) { int w = __builtin_amdgcn_cvt_pk_bf8_f32(p0[4 * q], p0[4 * q + 1], 0, false); w = __builtin_amdgcn_cvt_pk_bf8_f32(p0[4 * q + 2], p0[4 * q + 3], w, true); pa[q] = w;
    int u = __builtin_amdgcn_cvt_pk_bf8_f32(p1[4 * q], p1[4 * q + 1], 0, false); u = __builtin_amdgcn_cvt_pk_bf8_f32(p1[4 * q + 2], p1[4 * q + 3], u, true); pa[4 + q] = u; }
}
__device__ __forceinline__ void pv8(f32x16* o, const char* Vs, const v8i_a& pa, int r32, int hi) {
  v8i_a vf[4];
#pragma unroll
  for (int d0 = 0; d0 < 4; ++d0) { const char* p = Vs + (32 * d0 + r32) * VT_PITCH + 32 * hi;
    const v4i_a lo = *reinterpret_cast<const v4i_a*>(p), h4 = *reinterpret_cast<const v4i_a*>(p + 16); vf[d0] = __builtin_shufflevector(lo, h4, 0, 1, 2, 3, 4, 5, 6, 7); }
  asm volatile("s_nop 1\n\tv_mfma_f32_32x32x64_f8f6f4 %0, %1, %2, %0 cbsz:1" : "+v"(o[0]) : "v"(pa), "v"(vf[0]));
  asm volatile("v_mfma_f32_32x32x64_f8f6f4 %0, %1, %2, %0 cbsz:1" : "+v"(o[1]) : "v"(pa), "v"(vf[1]));
  asm volatile("v_mfma_f32_32x32x64_f8f6f4 %0, %1, %2, %0 cbsz:1" : "+v"(o[2]) : "v"(pa), "v"(vf[2]));
  asm volatile("v_mfma_f32_32x32x64_f8f6f4 %0, %1, %2, %0 cbsz:1" : "+v"(o[3]) : "v"(pa), "v"(vf[3]));
}
constexpr size_t SHM_ATTN8 = 3 * SHM_VT + 3 * SHM_K8 + NW * 64 * 4;
__device__ __forceinline__ void attn_dense_body3(const unsigned char* __restrict__ Qb, const unsigned char* __restrict__ Kh, const unsigned char* __restrict__ Vt,
                                                 const bf16_t* __restrict__ Gb, bf16_t* __restrict__ Ob, int seq, char* lds, float mfixC) {
  constexpr int VP2 = 144, SLOT_V = 128 * VP2, SLOT_K = 128 * 128;
  int tid_o = threadIdx.x; asm volatile("" : "+v"(tid_o));
  const int tid = tid_o, wid = tid >> 6, lane = tid & 63, r32 = lane & 31, hi = lane >> 5;
  char* V_lds = lds; char* K_lds = lds + 3 * SLOT_V;
  float* li_l = (float*)(lds + 3 * SLOT_V + 3 * SLOT_K) + wid * 64;
  float l_reg = 0; f32x16 o[4] = {}; v8i_a qf[2]; f32x16 cneg;
#pragma unroll
  for (int r = 0; r < 16; ++r) cneg[r] = -mfixC;
  { const unsigned char* Qw = Qb + (long)(wid * QBLK + r32) * 2048 + hi * 32;
#pragma unroll
    for (int t = 0; t < 2; ++t) { const v4i_a lo = *reinterpret_cast<const v4i_a*>(Qw + 64 * t), h4 = *reinterpret_cast<const v4i_a*>(Qw + 64 * t + 16); qf[t] = __builtin_shufflevector(lo, h4, 0, 1, 2, 3, 4, 5, 6, 7); } }
  const int kr = tid >> 3, kcb = (tid & 7) * 16, kst = KSWZ8(kr, kcb);
  const int vd = tid >> 2, vcb = (tid & 3) * 16, vst = vd * VP2 + vcb;
  struct { v4i_a v0, v1, k0, k1; } sg;
  const long SKV_ = seq;
#define SLOAD(p0) do { sg.v0 = *reinterpret_cast<const v4i_a*>(Vt + (long)vd * SKV_ + (p0) + vcb); sg.v1 = *reinterpret_cast<const v4i_a*>(Vt + (long)vd * SKV_ + (p0) + 64 + vcb); \
    sg.k0 = *reinterpret_cast<const v4i_a*>(Kh + (long)((p0) + kr) * 512 + kcb); sg.k1 = *reinterpret_cast<const v4i_a*>(Kh + (long)((p0) + 64 + kr) * 512 + kcb); } while (0)
#define SWRITE(slot) do { *(v4i_a*)(V_lds + (slot) * SLOT_V + vst) = sg.v0; *(v4i_a*)(V_lds + (slot) * SLOT_V + vst + 64) = sg.v1; \
    *(v4i_a*)(K_lds + (slot) * SLOT_K + kst) = sg.k0; *(v4i_a*)(K_lds + (slot) * SLOT_K + 64 * 128 + kst) = sg.k1; } while (0)
#define SWAIT() asm volatile("s_waitcnt vmcnt(0)" ::: "memory")
  f32x16 pA0, pA1, pB0, pB1; v8i_a pa = {}; const int NP = seq / (2 * KVBLK);
#define LD32(p) __builtin_shufflevector(*reinterpret_cast<const v4i_a*>(p), *reinterpret_cast<const v4i_a*>((p) + 16), 0, 1, 2, 3, 4, 5, 6, 7)
#define FSM_CHUNK(P0, P1, c) do { _Pragma("unroll") for (int r_ = 4 * (c); r_ < 4 * (c) + 4; ++r_) P1[r_] = __builtin_amdgcn_exp2f(P1[r_]); \
    ps_ += ((P0[4 * (c)] + P0[4 * (c) + 1]) + (P0[4 * (c) + 2] + P0[4 * (c) + 3])) + ((P1[4 * (c)] + P1[4 * (c) + 1]) + (P1[4 * (c) + 2] + P1[4 * (c) + 3])); \
    { int w_ = __builtin_amdgcn_cvt_pk_bf8_f32(P0[4 * (c)], P0[4 * (c) + 1], pa[c], false); w_ = __builtin_amdgcn_cvt_pk_bf8_f32(P0[4 * (c) + 2], P0[4 * (c) + 3], w_, true); pa[c] = w_; \
      int u_ = __builtin_amdgcn_cvt_pk_bf8_f32(P1[4 * (c)], P1[4 * (c) + 1], pa[4 + (c)], false); u_ = __builtin_amdgcn_cvt_pk_bf8_f32(P1[4 * (c) + 2], P1[4 * (c) + 3], u_, true); pa[4 + (c)] = u_; } } while (0)
#define FSM_END() do { auto rr_ = __builtin_amdgcn_permlane32_swap(__float_as_uint(ps_), __float_as_uint(ps_), false, false); l_reg += __uint_as_float(rr_[0]) + __uint_as_float(rr_[1]); } while (0)
#define EXP_CHUNK(P0, c) do { _Pragma("unroll") for (int r_ = 4 * (c); r_ < 4 * (c) + 4; ++r_) P0[r_] = __builtin_amdgcn_exp2f(P0[r_]); } while (0)
#define MF_QK0(P, KF) asm volatile("v_mfma_f32_32x32x64_f8f6f4 %0, %1, %2, %3" : "=&v"(P) : "v"(KF), "v"(qf[0]), "v"(cneg))
#define MF_QK1(P, KF) asm volatile("v_mfma_f32_32x32x64_f8f6f4 %0, %1, %2, %0" : "+v"(P) : "v"(KF), "v"(qf[1]))
#define MF_PV(O, VF) asm volatile("v_mfma_f32_32x32x64_f8f6f4 %0, %1, %2, %0 cbsz:1" : "+v"(O) : "v"(pa), "v"(VF))
#define LOADK(KS) const char* ks_ = (KS); v8i_a kf_[2][2]; \
    _Pragma("unroll") for (int kh_ = 0; kh_ < 2; ++kh_) _Pragma("unroll") for (int t_ = 0; t_ < 2; ++t_) { const int row_ = 32 * kh_ + r32, cb_ = 64 * t_ + 32 * hi; \
      const v4i_a lo_ = *reinterpret_cast<const v4i_a*>(ks_ + KSWZ8(row_, cb_)), hi_ = *reinterpret_cast<const v4i_a*>(ks_ + KSWZ8(row_, cb_ + 16)); kf_[kh_][t_] = __builtin_shufflevector(lo_, hi_, 0, 1, 2, 3, 4, 5, 6, 7); }
#define STEP_QK(KS, N0, N1, F0, F1) do { LOADK(KS) float ps_ = 0.f; SBAR(); \
    MF_QK0(N0, kf_[0][0]); SBAR(); FSM_CHUNK(F0, F1, 0); SBAR(); \
    MF_QK0(N1, kf_[1][0]); SBAR(); FSM_CHUNK(F0, F1, 1); SBAR(); \
    MF_QK1(N0, kf_[0][1]); SBAR(); FSM_CHUNK(F0, F1, 2); SBAR(); \
    MF_QK1(N1, kf_[1][1]); SBAR(); FSM_CHUNK(F0, F1, 3); FSM_END(); SBAR(); } while (0)
#define STEP_QK_ONLY(KS, N0, N1) do { LOADK(KS) SBAR(); MF_QK0(N0, kf_[0][0]); MF_QK0(N1, kf_[1][0]); MF_QK1(N0, kf_[0][1]); MF_QK1(N1, kf_[1][1]); SBAR(); } while (0)
#define STEP_PV(VS, E0) do { const char* vs_ = (VS) + r32 * VP2 + 32 * hi; v8i_a vf_[4]; \
    _Pragma("unroll") for (int d_ = 0; d_ < 4; ++d_) vf_[d_] = LD32(vs_ + 32 * d_ * VP2); \
    SBAR(); \
    MF_PV(o[0], vf_[0]); SBAR(); EXP_CHUNK(E0, 0); SBAR(); \
    MF_PV(o[1], vf_[1]); SBAR(); EXP_CHUNK(E0, 1); SBAR(); \
    MF_PV(o[2], vf_[2]); SBAR(); EXP_CHUNK(E0, 2); SBAR(); \
    MF_PV(o[3], vf_[3]); SBAR(); EXP_CHUNK(E0, 3); SBAR(); } while (0)
  SLOAD(0); SWAIT(); SWRITE(0); SLOAD(2 * KVBLK); __syncthreads();
  STEP_QK_ONLY(K_lds, pA0, pA1);
  asm volatile("s_nop 15\n\ts_nop 15\n\ts_nop 15\n\ts_nop 15\n\ts_nop 15" ::: "memory");
  EXP_CHUNK(pA0, 0); EXP_CHUNK(pA0, 1); EXP_CHUNK(pA0, 2); EXP_CHUNK(pA0, 3);
  STEP_QK(K_lds + 64 * 128, pB0, pB1, pA0, pA1);
  STEP_PV(V_lds, pB0);
  SWAIT(); SWRITE(1); if (2 < NP) SLOAD(4 * KVBLK); __syncthreads();
  int cur = 1, prv = 0, nxt = 2;
  for (int J = 1; J < NP; ++J) {
    STEP_QK(K_lds + cur * SLOT_K, pA0, pA1, pB0, pB1);
    STEP_PV(V_lds + prv * SLOT_V + 64, pA0);
    STEP_QK(K_lds + cur * SLOT_K + 64 * 128, pB0, pB1, pA0, pA1);
    STEP_PV(V_lds + cur * SLOT_V, pB0);
    if (J + 1 < NP) { SWAIT(); SWRITE(nxt); if (J + 2 < NP) SLOAD((long)(J + 2) * 2 * KVBLK); }
    __syncthreads();
    { const int t = prv; prv = cur; cur = nxt; nxt = t; }
  }
  { float ps_ = 0.f; asm volatile("s_nop 15\n\ts_nop 15\n\ts_nop 15\n\ts_nop 15\n\ts_nop 15" ::: "memory");
    FSM_CHUNK(pB0, pB1, 0); FSM_CHUNK(pB0, pB1, 1); FSM_CHUNK(pB0, pB1, 2); FSM_CHUNK(pB0, pB1, 3); FSM_END(); }
  { const char* vs_ = V_lds + prv * SLOT_V + 64 + r32 * VP2 + 32 * hi; v8i_a vf_[4];
#pragma unroll
    for (int d_ = 0; d_ < 4; ++d_) vf_[d_] = LD32(vs_ + 32 * d_ * VP2);
    MF_PV(o[0], vf_[0]); MF_PV(o[1], vf_[1]); MF_PV(o[2], vf_[2]); MF_PV(o[3], vf_[3]); }
  asm volatile("s_nop 15\n\ts_nop 15\n\ts_nop 15\n\ts_nop 15\n\ts_nop 15" ::: "memory");
  if (hi == 0) li_l[r32] = l_reg; asm volatile("s_waitcnt lgkmcnt(0)" ::: "memory");
  int tid2 = threadIdx.x; asm volatile("" : "+v"(tid2));
  const int lane_o = tid2 & 63, wid2 = tid2 >> 6, odd = lane_o & 1, ce = (lane_o & 30), hio = lane_o >> 5;
  const bf16_t* Gw = Gb + (long)(wid2 * QBLK) * 2048; unsigned char* Ow = (unsigned char*)Ob + (long)(wid2 * QBLK) * 6144;
#pragma unroll
  for (int r = 0; r < 16; r += 2) { const int rowa = crow(r, hio), rowme = rowa + odd;
    const float ra = __builtin_amdgcn_rcpf(li_l[rowa]), rb = __builtin_amdgcn_rcpf(li_l[rowa + 1]);
#pragma unroll
    for (int d0 = 0; d0 < 4; ++d0) { const float a = o[d0][r] * ra, b = o[d0][r + 1] * rb;
      const float send = odd ? a : b, recv = __shfl_xor(send, 1);
      const float v0 = odd ? recv : a, v1 = odd ? b : recv;
      const unsigned gw = *(const unsigned*)(Gw + (long)rowme * 2048 + d0 * 32 + ce);
      *(unsigned short*)(Ow + (long)rowme * 6144 + d0 * 32 + ce) = (unsigned short)__builtin_amdgcn_cvt_pk_fp8_f32(v0 * bf_lo(gw) * 8.f, v1 * bf_hi(gw) * 8.f, 0, false); } }
  __syncthreads();
#undef SLOAD
#undef SWRITE
#undef SWAIT
#undef LD32
#undef FSM_CHUNK
#undef FSM_END
#undef EXP_CHUNK
#undef MF_QK0
#undef MF_QK1
#undef MF_PV
#undef LOADK
#undef STEP_QK
#undef STEP_QK_ONLY
#undef STEP_PV
}
}

__device__ __forceinline__ unsigned f2bf(float f) { unsigned u = __builtin_bit_cast(unsigned, f); return (u + 0x7fffu + ((u >> 16) & 1u)) >> 16; }
__device__ __forceinline__ unsigned pk2(float lo, float hi) { return f2bf(lo) | (f2bf(hi) << 16); }
__device__ __forceinline__ float wave_sum(float v) {
#pragma unroll
    for (int o = 1; o < 64; o <<= 1) v += __shfl_xor(v, o);
    return v;
}
__device__ __forceinline__ int rowmap_in0(int n) {
    if (n >= 2560) return n;
    const int head = n >> 7, d = n & 127, axis = d >> 6, nn = (d >> 5) & 1, f = d & 31;
    return head * 128 + 32 * (2 * axis + (f >> 4)) + 8 * ((f & 15) >> 2) + 4 * nn + (f & 3);
}
__device__ __forceinline__ int rowmap_in1(int n) {
    const int part = n >> 12, ch = n & 4095, pn = ch >> 6, cc = ch & 63;
    return pn * 256 + 128 * (part >> 1) + 32 * (cc >> 4) + 16 * (part & 1) + (cc & 15);
}
__device__ __forceinline__ void transpose_load(const float* W, int N, int item, int lane, f32x4 (&v)[16]) {
    const int nblk = N / 64, kb = item / nblk, nb = item % nblk, k0 = 64 * kb, n0 = 64 * nb;
    const int c4 = lane & 15, r4 = lane >> 4;
    const float* src = W + (size_t)(k0 + r4) * N + n0 + 4 * c4;
#pragma unroll
    for (int i = 0; i < 16; ++i) v[i] = __builtin_nontemporal_load((const f32x4*)(src + (size_t)(4 * i) * N));
}
template <int MAP>
__device__ __forceinline__ void transpose_finish(const f32x4 (&v)[16], int K, int N, bf16_t* WT, LAS float* scr, int item, int lane) {
    const int nblk = N / 64, kb = item / nblk, nb = item % nblk, k0 = 64 * kb, n0 = 64 * nb;
    const int c4 = lane & 15, r4 = lane >> 4;
#pragma unroll
    for (int i = 0; i < 16; ++i) { LAS float* d = scr + (4 * i + r4) * 65 + 4 * c4; d[0] = v[i][0]; d[1] = v[i][1]; d[2] = v[i][2]; d[3] = v[i][3]; }
    LDS_WAIT(); asm volatile("" ::: "memory");
    if (MAP == 1 || MAP == 3 || (MAP == 4 && k0 < 2048)) {
        const int c = lane & 3, nn = lane >> 2; unsigned char* W8 = (unsigned char*)WT;
#pragma unroll
        for (int j = 0; j < 4; ++j) { const int n = nn + 16 * j; const LAS float* s = scr + (16 * c) * 65 + n; u32x4 o;
#pragma unroll
            for (int q = 0; q < 4; ++q) { int w = __builtin_amdgcn_cvt_pk_fp8_f32(s[(4 * q) * 65] * 256.f, s[(4 * q + 1) * 65] * 256.f, 0, false);
                w = __builtin_amdgcn_cvt_pk_fp8_f32(s[(4 * q + 2) * 65] * 256.f, s[(4 * q + 3) * 65] * 256.f, w, true); o[q] = (unsigned)w; }
            *(GAS u32x4*)(W8 + (MAP == 1 ? (size_t)rowmap_in0(n0 + n) * K : (MAP == 3 ? (size_t)(n0 + n) * K : (size_t)(n0 + n) * 6144)) + k0 + 16 * c) = o; }
        LDS_WAIT(); asm volatile("" ::: "memory");
        return;
    }
    const int c = lane & 7, nn = lane >> 3;
#pragma unroll
    for (int j = 0; j < 8; ++j) { const int n = nn + 8 * j; const LAS float* s = scr + (8 * c) * 65 + n;
        u32x4 o; o.x = cvt_pk_bf16(s[0], s[65]); o.y = cvt_pk_bf16(s[130], s[195]); o.z = cvt_pk_bf16(s[260], s[325]); o.w = cvt_pk_bf16(s[390], s[455]);
        const int ns = n0 + n, nd = MAP == 1 ? rowmap_in0(ns) : (MAP == 2 ? rowmap_in1(ns) : ns);
        if (MAP == 4) *(GAS u32x4*)((unsigned char*)WT + (size_t)nd * 6144 + 2048 + (size_t)(k0 - 2048) * 2 + 16 * c) = o;
        else *(GAS u32x4*)(WT + (size_t)nd * K + k0 + 8 * c) = o; }
    LDS_WAIT(); asm volatile("" ::: "memory");
}
template <int MAP>
__device__ __forceinline__ void transpose_item(const float* W, int K, int N, bf16_t* WT, LAS float* scr, int item, int lane) {
    f32x4 v[16]; transpose_load(W, N, item, lane, v); transpose_finish<MAP>(v, K, N, WT, scr, item, lane);
}
template <bool DELTA>
__device__ __forceinline__ void mod_load(const float* xrow, const bf16_t* drow, int lane, f32x4 (&v)[16], u32x2 (&d)[16]) {
#pragma unroll
    for (int j = 0; j < 16; ++j) { v[j] = __builtin_nontemporal_load((const f32x4*)(xrow + 256 * j + 4 * lane)); if (DELTA) d[j] = __builtin_nontemporal_load((const u32x2*)(drow + 256 * j + 4 * lane)); }
}
template <bool DELTA, bool OUT8 = false>
__device__ __forceinline__ void mod_finish(f32x4 (&v)[16], const u32x2 (&d)[16], const float* nw, const float* shift, const float* scale, bf16_t* orow, int lane) {
    float s = 0.f;
#pragma unroll
    for (int j = 0; j < 16; ++j) { if (DELTA) { v[j][0] += bf_lo(d[j].x); v[j][1] += bf_hi(d[j].x); v[j][2] += bf_lo(d[j].y); v[j][3] += bf_hi(d[j].y); }
        s += (v[j][0] * v[j][0] + v[j][1] * v[j][1]) + (v[j][2] * v[j][2] + v[j][3] * v[j][3]); }
    const float rstd = __builtin_amdgcn_rsqf(wave_sum(s) * (1.0f / DM) + EPS);
#pragma unroll
    for (int j = 0; j < 16; ++j) { const int c = 256 * j + 4 * lane; const f32x4 w = *(const f32x4*)(nw + c), sh = *(const f32x4*)(shift + c), sc = *(const f32x4*)(scale + c);
        const f32x4 o = v[j] * rstd * w * (sc + 1.0f) + sh;
        if (OUT8) { int w8 = __builtin_amdgcn_cvt_pk_fp8_f32(o[0], o[1], 0, false); w8 = __builtin_amdgcn_cvt_pk_fp8_f32(o[2], o[3], w8, true); __builtin_nontemporal_store(w8, (int*)((unsigned char*)orow + c)); }
        else { u32x2 p; p.x = cvt_pk_bf16(o[0], o[1]); p.y = cvt_pk_bf16(o[2], o[3]); __builtin_nontemporal_store(p, (u32x2*)(orow + c)); }
        if ((j & 3) == 3) asm volatile("" ::: "memory"); }
}
template <bool OUT8>
__device__ __forceinline__ void modulate_row(const float* xrow, const float* nw, const float* shift, const float* scale, bf16_t* orow, int lane) {
    f32x4 v[16]; u32x2 d[16]; mod_load<false>(xrow, nullptr, lane, v, d); mod_finish<false, OUT8>(v, d, nw, shift, scale, orow, lane);
}
template <bool DELTA>
__device__ __forceinline__ void modulate_rows(const float* X, const bf16_t* Dl, const float* nw, const float* mod, bf16_t* O, int m0, int step, int mend, int lane) {
    if (m0 >= mend) return;
    if (DELTA) {
        for (int m = m0; m < mend; m += step) { f32x4 v[16]; u32x2 d[16]; mod_load<DELTA>(X + (size_t)m * DM, Dl + (size_t)m * DM, lane, v, d);
            const float* md = mod + (m >> 13) * 12288; mod_finish<DELTA>(v, d, nw, md, md + 4096, O + (size_t)m * DM, lane); }
        return;
    }
    f32x4 va[16], vb[16]; u32x2 da[16], db[16];
    mod_load<DELTA>(X + (size_t)m0 * DM, Dl + (size_t)m0 * DM, lane, va, da);
    for (int m = m0; m < mend; m += 2 * step) {
        const int m1 = m + step, m2 = m + 2 * step;
        if (m1 < mend) mod_load<DELTA>(X + (size_t)m1 * DM, Dl + (size_t)m1 * DM, lane, vb, db);
        { const float* md = mod + (m >> 13) * 12288; mod_finish<DELTA>(va, da, nw, md, md + 4096, O + (size_t)m * DM, lane); }
        if (m1 >= mend) break;
        if (m2 < mend) mod_load<DELTA>(X + (size_t)m2 * DM, Dl + (size_t)m2 * DM, lane, va, da);
        { const float* md = mod + (m1 >> 13) * 12288; mod_finish<DELTA>(vb, db, nw, md, md + 4096, O + (size_t)m1 * DM, lane); }
    }
}

__global__ void __launch_bounds__(NTHREADS, 2) fwd_kernel(Args args) {
    extern __shared__ __attribute__((aligned(16))) unsigned char lds_raw[];
    LAS unsigned char* lds = (LAS unsigned char*)lds_raw;
    const int tid = threadIdx.x, lane = tid & 63, wave = __builtin_amdgcn_readfirstlane(tid >> 6);
    const int G = gridDim.x, bx = blockIdx.x;
    unsigned char* ws = args.ws;
    unsigned* ctl = (unsigned*)(ws + WS_CTL);
    volatile LAS unsigned* MISC = (volatile LAS unsigned*)(lds + LDSCTL_OFF);
    for (int u = tid; u < 128; u += NTHREADS) MISC[u] = 0u;
    __syncthreads();
    XcdBarrier bar; bar.bar = ctl + CW_BAR; bar.x = 0; bar.st = nullptr;
    if (MK_ONE_LAUNCH) bar = xcd_barrier_post(ctl + CW_BAR, MISC + 8);
    const int lo = args.ph_lo, hi = args.ph_hi;
#ifndef PH_MASK
#define PH_MASK 0x3fff
#endif
#define IN(k) (((PH_MASK >> (k)) & 1) && lo <= (k) && (k) < hi)
#define SEAM(k) do { if (IN(k) && IN((k) + 1)) xcd_barrier(bar); } while (0)
#ifndef DBL_MASK
#define DBL_MASK 0
#endif
#define PH_BEGIN(k) if (IN(k)) for (int rep_ = 0; rep_ <= ((DBL_MASK >> (k)) & 1); ++rep_) {
#define PH_END(k) if (rep_ < ((DBL_MASK >> (k)) & 1)) xcd_barrier(bar); }

    const float* x = args.in[0]; const float* cvec = args.in[1]; const float* ctxin = args.in[2]; const float* cctx = args.in[3];
    const float* l0_norm_w = args.in[4]; const float* l0_w_mod = args.in[5]; const float* l0_b_mod = args.in[6]; const float* l0_w_in = args.in[7];
    const float* l0_q_norm_w = args.in[8]; const float* l0_k_norm_w = args.in[9];
    const float* l0_ssm_d = args.in[24]; const float* l0_w_glu = args.in[25]; const float* l0_b_glu = args.in[26]; const float* l0_w_out = args.in[27];
    const float* l1_norm_w = args.in[28]; const float* l1_w_mod = args.in[29]; const float* l1_b_mod = args.in[30]; const float* l1_w_in = args.in[31];
    const float* l1_conv_w = args.in[32]; const float* l1_conv_b = args.in[33]; const float* l1_w_out = args.in[34];
    float* out = args.out;
    float* MOD = (float*)(ws + WS_MOD);
    float* SA1 = (float*)(ws + WS_SSMP + SSMP_A1); float* SA32 = (float*)(ws + WS_SSMP + SSMP_A32); float* SBB = (float*)(ws + WS_SSMP + SSMP_BB);
    float* ROPEC = (float*)(ws + WS_ROPE); float* ROPES = ROPEC + 128 * 32;
    float* YE = (float*)(ws + WS_YE); float* PP = (float*)(ws + WS_PP);
    bf16_t* UCTX = (bf16_t*)(ws + WS_UCTX);
    bf16_t* BT0 = (bf16_t*)(ws + WS_BT0); bf16_t* WGT = (bf16_t*)(ws + WS_WGT); bf16_t* WO0 = (bf16_t*)(ws + WS_WO0); bf16_t* BT1 = (bf16_t*)(ws + WS_BT1); bf16_t* WO1 = (bf16_t*)(ws + WS_WO1);
    bf16_t* PT = (bf16_t*)(ws + WS_PT); bf16_t* KMT = (bf16_t*)(ws + WS_KMT);
    bf16_t* XN = (bf16_t*)(ws + WS_XN); unsigned char* Q8B = ws + WS_XN + 68 * MiB; unsigned char* K8B = ws + WS_XN + 100 * MiB; unsigned char* V8TB = ws + WS_XN + 110 * MiB;     bf16_t* QB = (bf16_t*)(ws + WS_Q); bf16_t* KB = (bf16_t*)(ws + WS_K); bf16_t* VB = (bf16_t*)(ws + WS_V);
    bf16_t* GA = (bf16_t*)(ws + WS_GA); bf16_t* GS = (bf16_t*)(ws + WS_GS); bf16_t* M1 = (bf16_t*)(ws + WS_M1);
    bf16_t* D0 = (bf16_t*)(ws + WS_D0); unsigned char* YG8 = ws + WS_MIX + 96 * MiB;     bf16_t* AS = (bf16_t*)(ws + WS_AS); bf16_t* YG = (bf16_t*)(ws + WS_YG); bf16_t* MIX = (bf16_t*)(ws + WS_MIX); float* SB = (float*)(ws + WS_S);

    PH_BEGIN(0)
        for (int i = bx * NTHREADS + tid; i < 128 * 32; i += G * NTHREADS) { const int pos = i >> 5, f = i & 31;
            const float inv = exp2f(-(float)(2 * f) * (13.287712379549449f / 64.0f)); float sn, cs; sincosf((float)pos * inv, &sn, &cs); ROPEC[i] = cs; ROPES[i] = sn; }
        constexpr int I0 = 64 * (NIN0 / 64), IG = 32 * 32, IO = 64 * 64, I1 = 64 * (NIN1 / 64);
        constexpr int NTR = I0 + IG, NQ = 192 + 256 + NTR / 8;
        static_assert(NTR % 8 == 0, "weight-copy items come in batches of 8");
        volatile LAS int* qslot = (volatile LAS int*)(lds + LDSCTL_OFF + 256);
        for (;;) {
            if (tid == 0) *qslot = (int)atomicAdd(ctl + CW_QCTR + 64 * rep_, 1u);
            __syncthreads();
            const int qit = __builtin_amdgcn_readfirstlane(*qslot);
            __syncthreads();
            if (qit >= NQ) break;
            if (qit < 192)
            { const int it = qit;
            const int layer = it / 96, chunk = it % 96; const float* W = layer ? l1_w_mod : l0_w_mod; const float* bm = layer ? l1_b_mod : l0_b_mod;
            LAS float* sc = (LAS float*)lds;
            LAS float* red = (LAS float*)(lds + 49152);
            for (int i = tid; i < 3 * 4096; i += NTHREADS) { const int v = i >> 12, k = i & 4095; const float cv = v < 2 ? cvec[v * 4096 + k] : cctx[k]; sc[i] = siluf_(cv); }
            __syncthreads();
            f32x4 a0 = (f32x4){0.f, 0.f, 0.f, 0.f}, a1 = a0, a2 = a0;
            const int kr = lane >> 5, c4 = (lane & 31) * 4; const float* wp = W + (size_t)(wave * 512 + kr) * 12288 + chunk * 128 + c4;
            f32x4 wa[8], wb[8];
#define GV_LOAD(dst, i0) do { _Pragma("unroll") for (int q_ = 0; q_ < 8; ++q_) dst[q_] = __builtin_nontemporal_load((const f32x4*)(wp + (size_t)(2 * ((i0) + q_)) * 12288)); asm volatile("" ::: "memory"); } while (0)
#define GV_USE(src, i0) do { _Pragma("unroll") for (int q_ = 0; q_ < 8; ++q_) { const int k = wave * 512 + 2 * ((i0) + q_) + kr; a0 += src[q_] * sc[k]; a1 += src[q_] * sc[4096 + k]; a2 += src[q_] * sc[8192 + k]; } } while (0)
            GV_LOAD(wa, 0);
            for (int i0 = 0; i0 < 256; i0 += 16) {
                GV_LOAD(wb, i0 + 8);
                GV_USE(wa, i0);
                if (i0 + 16 < 256) GV_LOAD(wa, i0 + 16);
                GV_USE(wb, i0 + 8);
            }
#undef GV_LOAD
#undef GV_USE
#pragma unroll
            for (int e = 0; e < 4; ++e) { a0[e] += __shfl_xor(a0[e], 32); a1[e] += __shfl_xor(a1[e], 32); a2[e] += __shfl_xor(a2[e], 32); }
            if (lane < 32) { *(LAS f32x4*)(red + (wave * 3 + 0) * 128 + c4) = a0; *(LAS f32x4*)(red + (wave * 3 + 1) * 128 + c4) = a1; *(LAS f32x4*)(red + (wave * 3 + 2) * 128 + c4) = a2; }
            __syncthreads();
            if (tid < 384) { const int v = tid >> 7, col = tid & 127; float s = 0.f;
#pragma unroll
                for (int w = 0; w < 8; ++w) s += red[(w * 3 + v) * 128 + col];
                MOD[(layer * 3 + v) * 12288 + chunk * 128 + col] = s + bm[chunk * 128 + col]; }
            __syncthreads();
        }
            else if (qit < 448)
            { const int it = qit - 192;
            const int g = it >> 1, hf = it & 1;
            LAS float* AP = (LAS float*)lds;
            LAS float* BB = (LAS float*)(lds + 33792);
            LAS float* CC = (LAS float*)(lds + 33792 + 16384);
            LAS float* KT = (LAS float*)(lds + 33792 + 32768);
            if (tid < 128) { const int dir = tid >> 6, p = tid & 63; const int ib = 10 + 7 * dir;
                const float lr = args.in[ib][g * 64 + p], li = args.in[ib + 1][g * 64 + p], dt = expf(args.in[ib + 2][g]);
                const float mag = expf(lr * dt); float sn, cs; sincosf(li * dt, &sn, &cs); const float ar = mag * cs, aim = mag * sn;
                float pr = 1.f, pi = 0.f;
                for (int k = 0; k <= 32; ++k) { AP[((dir * 33 + k) * 64 + p) * 2] = pr; AP[((dir * 33 + k) * 64 + p) * 2 + 1] = pi;
                    if (k == 1 && hf == 0) { SA1[((dir * 128 + g) * 64 + p) * 2] = pr; SA1[((dir * 128 + g) * 64 + p) * 2 + 1] = pi; }
                    if (k == 32 && hf == 0) { SA32[((dir * 128 + g) * 64 + p) * 2] = pr; SA32[((dir * 128 + g) * 64 + p) * 2 + 1] = pi; }
                    const float nr = pr * ar - pi * aim, ni = pr * aim + pi * ar; pr = nr; pi = ni; }
                const float den = lr * lr + li * li, nre = ar - 1.0f, cr = (nre * lr + aim * li) / den, ci = (aim * lr - nre * li) / den;
                for (int j = 0; j < 16; ++j) { const float br = args.in[ib + 3][(g * 64 + p) * 16 + j], bi = args.in[ib + 4][(g * 64 + p) * 16 + j];
                    const float vr = cr * br - ci * bi, vi = cr * bi + ci * br; BB[((dir * 64 + p) * 16 + j) * 2] = vr; BB[((dir * 64 + p) * 16 + j) * 2 + 1] = vi;
                    if (hf == 0) { SBB[(((size_t)(dir * 128 + g) * 64 + p) * 16 + j) * 2] = vr; SBB[(((size_t)(dir * 128 + g) * 64 + p) * 16 + j) * 2 + 1] = vi; } }
                for (int i = 0; i < 16; ++i) { CC[((dir * 16 + i) * 64 + p) * 2] = args.in[ib + 5][(g * 16 + i) * 64 + p]; CC[((dir * 16 + i) * 64 + p) * 2 + 1] = args.in[ib + 6][(g * 16 + i) * 64 + p]; }
            }
            __syncthreads();
            for (int pr_ = tid; pr_ < 63 * 16; pr_ += NTHREADS) { const int dd = pr_ >> 4, i = pr_ & 15, d = dd - 31;
                float accj[16];
#pragma unroll
                for (int j = 0; j < 16; ++j) accj[j] = 0.f;
#pragma unroll
                for (int dir = 0; dir < 2; ++dir) { const bool use = dir == 0 ? d >= 0 : d <= 0; const int k = d >= 0 ? d : -d;
                    if (use) for (int p = 0; p < 64; ++p) { const f32x2 c = *(const LAS f32x2*)(CC + ((dir * 16 + i) * 64 + p) * 2), a = *(const LAS f32x2*)(AP + ((dir * 33 + k) * 64 + p) * 2);
                        const float car = c.x * a.x - c.y * a.y, cai = c.x * a.y + c.y * a.x;
#pragma unroll
                        for (int j4 = 0; j4 < 8; ++j4) { const f32x4 b = *(const LAS f32x4*)(BB + ((dir * 64 + p) * 16 + 2 * j4) * 2);
                            accj[2 * j4] += car * b[0] - cai * b[1]; accj[2 * j4 + 1] += car * b[2] - cai * b[3]; } } }
                if (d == 0) { const float dv = l0_ssm_d[g * 16 + i];
#pragma unroll
                    for (int j = 0; j < 16; ++j) accj[j] += (j == i) ? dv : 0.f; }
#pragma unroll
                for (int j = 0; j < 16; ++j) KT[(dd * 16 + i) * 16 + j] = accj[j]; }
            __syncthreads();
            bf16_t* kmt = KMT + (size_t)g * 512 * 768;
            for (int cidx = tid; cidx < 256 * 64; cidx += NTHREADS) { const int nl = cidx >> 6, kc = cidx & 63, n = hf * 256 + nl, tau = n >> 4, i = n & 15, s = kc >> 1, j0 = (kc & 1) * 8;
                const LAS float* kp = KT + ((tau - s + 31) * 16 + i) * 16 + j0; const f32x4 a = *(const LAS f32x4*)kp, b = *(const LAS f32x4*)(kp + 4);
                u32x4 o; o.x = cvt_pk_bf16(a[0], a[1]); o.y = cvt_pk_bf16(a[2], a[3]); o.z = cvt_pk_bf16(b[0], b[1]); o.w = cvt_pk_bf16(b[2], b[3]);
                *(u32x4*)(kmt + (size_t)n * 768 + kc * 8) = o; }
            for (int cidx = tid; cidx < 256 * 32; cidx += NTHREADS) { const int nl = cidx >> 5, kc = cidx & 31, n = hf * 256 + nl, tau = n >> 4, i = n & 15, q = kc >> 3, p0 = (kc & 7) * 8, dir = q >> 1;
                const int k = dir == 0 ? tau + 1 : 32 - tau; float v[8];
#pragma unroll
                for (int e = 0; e < 8; ++e) { const int p = p0 + e; const f32x2 c = *(const LAS f32x2*)(CC + ((dir * 16 + i) * 64 + p) * 2), a = *(const LAS f32x2*)(AP + ((dir * 33 + k) * 64 + p) * 2);
                    v[e] = (q & 1) ? -(c.x * a.y + c.y * a.x) : (c.x * a.x - c.y * a.y); }
                u32x4 o; o.x = cvt_pk_bf16(v[0], v[1]); o.y = cvt_pk_bf16(v[2], v[3]); o.z = cvt_pk_bf16(v[4], v[5]); o.w = cvt_pk_bf16(v[6], v[7]);
                *(u32x4*)(kmt + (size_t)n * 768 + 512 + kc * 8) = o; }
            bf16_t* pt = PT + (size_t)g * 256 * 512;
            for (int cidx = tid; cidx < 128 * 64; cidx += NTHREADS) { const int nl = cidx >> 6, kc = cidx & 63, np = hf * 128 + nl, q = np >> 6, p = np & 63, dir = hf, tau = kc >> 1, j0 = (kc & 1) * 8;
                const int k = dir == 0 ? 31 - tau : tau; const f32x2 a = *(const LAS f32x2*)(AP + ((dir * 33 + k) * 64 + p) * 2); float v[8];
#pragma unroll
                for (int e = 0; e < 8; ++e) { const f32x2 b = *(const LAS f32x2*)(BB + ((dir * 64 + p) * 16 + j0 + e) * 2); v[e] = (q & 1) ? (a.x * b.y + a.y * b.x) : (a.x * b.x - a.y * b.y); }
                u32x4 o; o.x = cvt_pk_bf16(v[0], v[1]); o.y = cvt_pk_bf16(v[2], v[3]); o.z = cvt_pk_bf16(v[4], v[5]); o.w = cvt_pk_bf16(v[6], v[7]);
                *(u32x4*)(pt + (size_t)np * 512 + kc * 8) = o; }
            __syncthreads();
        }
            else { LAS float* scr = (LAS float*)(lds + wave * 16640); int r = (qit - 448) * 8 + wave;
                if (r < I0) transpose_item<1>(l0_w_in, DM, NIN0, BT0, scr, r, lane);
                else { r -= I0; transpose_item<3>(l0_w_glu, 2048, 2048, WGT, scr, r, lane); } }
        }
    PH_END(0)
    SEAM(0);

    PH_BEGIN(1)
    PH_END(1)

    PH_BEGIN(2)
        if (bx < 24 && G > 24) {
            for (int m = bx * NWAVES + wave; m < MCTX; m += 24 * NWAVES)
                modulate_row<true>(ctxin + (size_t)m * DM, l0_norm_w, MOD + 2 * 12288, MOD + 2 * 12288 + 4096, (bf16_t*)((unsigned char*)XN + (size_t)(MLAT + m) * DM), lane);
            asm volatile("s_waitcnt vmcnt(0)" ::: "memory");
            __syncthreads();
            if (tid == 0) { unsigned* gctr = ctl + 2048;
                __builtin_amdgcn_fence(__ATOMIC_RELEASE, "agent"); asm volatile("s_waitcnt vmcnt(0)" ::: "memory");
                (void)xb_add(gctr, 1u);
                XB_SPIN(xb_ld(gctr) < 24u * (unsigned)(rep_ + 1), ctl + CW_BAR);
                __builtin_amdgcn_fence(__ATOMIC_ACQUIRE, "agent"); asm volatile("s_waitcnt vmcnt(0)" ::: "memory"); }
            __syncthreads();
            pg8::Gemm g{XN, BT0, DM / 2, DM / 2, DM, 0}; CtxOrder S{bx};
            EpiIn0 E{QB, KB, VB, GA, GS, AS, UCTX, l0_q_norm_w, l0_k_norm_w, ROPEC, ROPES, (LAS float*)(lds + EPI_OFF), Q8B, K8B, V8TB};
            pg8::gemm_phase<EpiIn0, CtxOrder, true>(lds, g, S, E);
        } else {
            const int gw = (bx - 24) * NWAVES + wave, NGW = (G - 24) * NWAVES;
            for (int m = gw; m < MLAT; m += NGW) { const int v = m >> 13;
                modulate_row<true>(x + (size_t)m * DM, l0_norm_w, MOD + v * 12288, MOD + v * 12288 + 4096, (bf16_t*)((unsigned char*)XN + (size_t)m * DM), lane); }
        }
    PH_END(2)
    SEAM(2);

    PH_BEGIN(3)
        pg8::Gemm g{XN, BT0, DM / 2, DM / 2, DM, 0}; pg8::StaticOrder S; S.init(MLAT, NIN0, G, bx);
        EpiIn0 E{QB, KB, VB, GA, GS, AS, UCTX, l0_q_norm_w, l0_k_norm_w, ROPEC, ROPES, (LAS float*)(lds + EPI_OFF), Q8B, K8B, V8TB};
        pg8::gemm_phase<EpiIn0, pg8::StaticOrder, true>(lds, g, S, E);
    PH_END(3)
    SEAM(3);

    PH_BEGIN(4)
        pg8::Gemm g{AS, PT, 768, 512, 512, 0}; SsmSOrder S{G, bx}; EpiS E{SB};
        pg8::gemm_phase<EpiS, SsmSOrder>(lds, g, S, E);
    PH_END(4)
    if (G == 256) { if (IN(4) && IN(5)) { asm volatile("s_waitcnt vmcnt(0)" ::: "memory"); __builtin_amdgcn_fence(__ATOMIC_RELEASE, "workgroup"); __syncthreads(); __builtin_amdgcn_fence(__ATOMIC_ACQUIRE, "workgroup"); } }
    else SEAM(4);

    PH_BEGIN(5)
        for (int it = bx; it < 256; it += G) {
            const int b = it >> 7, g = it & 127;
            LAS float* SL = (LAS float*)lds;
            const int dir = (tid >> 6) & 1, p = tid & 63;
            float hr = 0.f, hi_ = 0.f, a32r = 0.f, a32i = 0.f;
            { LAS float* BU = (LAS float*)lds; LAS unsigned char* UL = lds + 131072;
              const bf16_t* uc = UCTX + (size_t)(b * NGRP + g) * CTXL * 16;
              *(LAS u32x4*)(UL + tid * 16) = *(const u32x4*)(uc + tid * 8);
              float br[16], bi[16];
#pragma unroll
              for (int j = 0; j < 16; j += 2) { const f32x4 v = *(const f32x4*)(SBB + (((size_t)(dir * 128 + g) * 64 + p) * 16 + j) * 2); br[j] = v[0]; bi[j] = v[1]; br[j + 1] = v[2]; bi[j + 1] = v[3]; }
              float a1r = 0.f, a1i = 0.f;
              if (tid < 128) { a1r = SA1[((dir * 128 + g) * 64 + p) * 2]; a1i = SA1[((dir * 128 + g) * 64 + p) * 2 + 1];
                  a32r = SA32[((dir * 128 + g) * 64 + p) * 2]; a32i = SA32[((dir * 128 + g) * 64 + p) * 2 + 1]; }
              const int sgrp = tid >> 7;
              for (int half = 0; half < 2; ++half) {
                  __syncthreads();
#pragma unroll 2
                  for (int sl = sgrp * 32; sl < sgrp * 32 + 32; ++sl) { const int so = half * 128 + sl, ss = dir == 0 ? so : CTXL - 1 - so;
                      const u32x4 w0 = *(const LAS u32x4*)(UL + ss * 32), w1 = *(const LAS u32x4*)(UL + ss * 32 + 16);
                      const float uu[16] = {bf_lo(w0.x), bf_hi(w0.x), bf_lo(w0.y), bf_hi(w0.y), bf_lo(w0.z), bf_hi(w0.z), bf_lo(w0.w), bf_hi(w0.w),
                                            bf_lo(w1.x), bf_hi(w1.x), bf_lo(w1.y), bf_hi(w1.y), bf_lo(w1.z), bf_hi(w1.z), bf_lo(w1.w), bf_hi(w1.w)};
                      float xr = 0.f, xi = 0.f;
#pragma unroll
                      for (int j = 0; j < 16; ++j) { xr += br[j] * uu[j]; xi += bi[j] * uu[j]; }
                      f32x2 o; o.x = xr; o.y = xi; *(LAS f32x2*)(BU + ((dir * 128 + sl) * 64 + p) * 2) = o; }
                  __syncthreads();
                  if (tid < 128) {
#pragma unroll 8
                      for (int sl = 0; sl < 128; ++sl) { const f32x2 x = *(const LAS f32x2*)(BU + ((dir * 128 + sl) * 64 + p) * 2);
                          const float nr = a1r * hr - a1i * hi_ + x.x, ni = a1r * hi_ + a1i * hr + x.y; hr = nr; hi_ = ni; } }
              }
              __syncthreads(); }
            for (int i = tid; i < 256 * 32; i += NTHREADS) { const int c = i >> 5, q4 = (i & 31) * 4; *(LAS f32x4*)(SL + c * 128 + q4) = *(const f32x4*)(SB + ((size_t)it * 256 + c) * 256 + q4); }
            __syncthreads();
            bf16_t* asrow = AS + (size_t)it * 256 * 768 + 512;
            if (tid < 64) {
#pragma unroll 8
                for (int c = 0; c < 256; ++c) { const float sr = SL[c * 128 + p], si = SL[c * 128 + 64 + p]; SL[c * 128 + p] = hr; SL[c * 128 + 64 + p] = hi_;
                    const float nr = a32r * hr - a32i * hi_ + sr, ni = a32r * hi_ + a32i * hr + si; hr = nr; hi_ = ni; }
            }
            __syncthreads();
            for (int i = tid; i < 256 * 64; i += NTHREADS) { const int c = i >> 6, q2 = (i & 63) * 2; const f32x2 h2 = *(const LAS f32x2*)(SL + c * 128 + q2);
                *(unsigned*)(asrow + (size_t)c * 768 + q2) = cvt_pk_bf16(h2.x, h2.y); }
            __syncthreads();
            for (int i = tid; i < 256 * 32; i += NTHREADS) { const int c = i >> 5, q4 = (i & 31) * 4; *(LAS f32x4*)(SL + c * 128 + q4) = *(const f32x4*)(SB + ((size_t)it * 256 + c) * 256 + 128 + q4); }
            __syncthreads();
            if (tid >= 64 && tid < 128) {
#pragma unroll 8
                for (int c = 255; c >= 0; --c) { const float sr = SL[c * 128 + p], si = SL[c * 128 + 64 + p]; SL[c * 128 + p] = hr; SL[c * 128 + 64 + p] = hi_;
                    const float nr = a32r * hr - a32i * hi_ + sr, ni = a32r * hi_ + a32i * hr + si; hr = nr; hi_ = ni; }
            }
            __syncthreads();
            for (int i = tid; i < 256 * 64; i += NTHREADS) { const int c = i >> 6, q2 = (i & 63) * 2; const f32x2 h2 = *(const LAS f32x2*)(SL + c * 128 + q2);
                *(unsigned*)(asrow + (size_t)c * 768 + 128 + q2) = cvt_pk_bf16(h2.x, h2.y); }
            __syncthreads();
        }
    PH_END(5)
    if (G == 256) { if (IN(5) && IN(6)) { asm volatile("s_waitcnt vmcnt(0)" ::: "memory"); __builtin_amdgcn_fence(__ATOMIC_RELEASE, "workgroup"); __syncthreads(); __builtin_amdgcn_fence(__ATOMIC_ACQUIRE, "workgroup"); } }
    else SEAM(5);

    PH_BEGIN(6)
        pg8::Gemm g{AS, KMT, 768, 768, 768, 0}; SsmYOrder S{G, bx}; EpiY E{YG, YG8};
        pg8::gemm_phase<EpiY, SsmYOrder>(lds, g, S, E);
    PH_END(6)
    SEAM(6);

    PH_BEGIN(7)
        pg8::Gemm g{(const bf16_t*)YG8, WGT, 1024, 1024, 1024, 16}; pg8::StaticOrder S; S.init(MLAT, 2048, G, bx); EpiGlu E{YG, GS, l0_b_glu, MIX};
        pg8::gemm_phase<EpiGlu, pg8::StaticOrder, 2>(lds, g, S, E);
    PH_END(7)

    PH_BEGIN(8)
        float mq = fmaxf(fabsf(l0_q_norm_w[lane]), fabsf(l0_q_norm_w[lane + 64])), mk = fmaxf(fabsf(l0_k_norm_w[lane]), fabsf(l0_k_norm_w[lane + 64]));
#pragma unroll
        for (int o = 1; o < 64; o <<= 1) { mq = fmaxf(mq, __shfl_xor(mq, o)); mk = fmaxf(mk, __shfl_xor(mk, o)); }
        const float mfixC = 128.0f * mq * mk * 1.13f * QK_LOG2_SCALE;
        const bool fixmax = mfixC < 24.0f;
#ifndef ATT_FORCE_PREPASS
#define ATT_FORCE_PREPASS 0
#endif
        constexpr int L1_I1 = 64 * (NIN1 / 64), L1_I2 = L1_I1 + 64 * 64, L1_ITEMS = L1_I2 + 64 * 64;
        const int l1_per = (L1_ITEMS + G * NWAVES - 1) / (G * NWAVES), l1_slot = (bx & 7) % 5;
        auto l1_copies = [&]() {
            __syncthreads();
            int tid_c = threadIdx.x; asm volatile("" : "+v"(tid_c));
            const int lane_c = tid_c & 63, wave_c = __builtin_amdgcn_readfirstlane(tid_c >> 6);
            LAS float* scr = (LAS float*)(lds + wave_c * 16640);
            auto ld = [&](int r, f32x4 (&v)[16]) { if (r < L1_I1) transpose_load(l1_w_in, NIN1, r, lane_c, v); else if (r < L1_I2) transpose_load(l1_w_out, DM, r - L1_I1, lane_c, v); else if (r < L1_ITEMS) transpose_load(l0_w_out, DM, r - L1_I2, lane_c, v); };
            auto fin = [&](int r, const f32x4 (&v)[16]) { if (r < L1_I1) transpose_finish<2>(v, DM, NIN1, BT1, scr, r, lane_c); else if (r < L1_I2) transpose_finish<0>(v, DM, DM, WO1, scr, r - L1_I1, lane_c); else if (r < L1_ITEMS) transpose_finish<4>(v, DM, DM, WO0, scr, r - L1_I2, lane_c); };
            f32x4 va[16], vb[16]; const int rb = bx * l1_per * NWAVES + wave_c;
            ld(rb, va);
            for (int j = 0; j < l1_per; j += 2) {
                if (j + 1 < l1_per) ld(rb + (j + 1) * NWAVES, vb);
                asm volatile("" ::: "memory");
                fin(rb + j * NWAVES, va);
                if (j + 1 >= l1_per) break;
                if (j + 2 < l1_per) ld(rb + (j + 2) * NWAVES, va);
                asm volatile("" ::: "memory");
                fin(rb + (j + 1) * NWAVES, vb); }
            __syncthreads();
        };
        int kk = 0;
        for (int L = bx; L < 1024; L += G, ++kk) { int b = L >> 9, h = (L >> 5) & 15, qb = L & 31;
            if (G == 256) {
                const int xc = bx & 7, mm = bx >> 3;
                b = xc >> 2; h = ((xc + kk) & 3) * 4 + (mm & 3); qb = (mm >> 2) + 8 * (xc & 3); }
            const int kvh = h >> 2; const size_t qrow = (size_t)b * SEQ + qb * 256;
            if (kk == l1_slot) l1_copies();
            const unsigned char* Qp = Q8B + qrow * 2048 + h * 128; const unsigned char* Kp = K8B + (size_t)b * SKV * 512 + kvh * 128;
            float sh = mfixC;
            if (ATT_FORCE_PREPASS || !fixmax) sh = att::attn_rowmax(Qp, Kp, SKV, (char*)lds_raw);
            att::attn_dense_body3(Qp, Kp, V8TB + (size_t)(b * 4 + kvh) * 128 * SKV, GA + qrow * 2048 + h * 128, (bf16_t*)((unsigned char*)MIX + qrow * 6144 + h * 128), SKV, (char*)lds_raw, sh - 15.0f); }
        if (l1_slot >= kk) l1_copies();
    PH_END(8)
    SEAM(8);

    PH_BEGIN(9)
        pg8::Gemm g{MIX, WO0, 3072, 3072, 3072, 16}; pg8::StaticOrder S; S.init(MLAT, DM, G, bx); EpiDelta E{D0, MOD + 8192};
        pg8::gemm_phase<EpiDelta, pg8::StaticOrder, 2>(lds, g, S, E);
    PH_END(9)
    SEAM(9);

    PH_BEGIN(10)
        const int gw = bx * NWAVES + wave, NGW = G * NWAVES;
        modulate_rows<true>(x, D0, l1_norm_w, MOD + 3 * 12288, XN, gw, NGW, MLAT, lane);
    PH_END(10)
    SEAM(10);

    PH_BEGIN(11)
        pg8::Gemm g{XN, BT1, DM, DM, DM, 0}; pg8::StaticOrder S; S.init(MLAT, NIN1, G, bx);
        EpiConv E{M1, l1_conv_w, l1_conv_b, YE, PP, (LAS float*)(lds + EPI_OFF)};
        pg8::gemm_phase<EpiConv, pg8::StaticOrder>(lds, g, S, E);
    PH_END(11)
    SEAM(11);

    PH_BEGIN(12)
        for (int idx = bx * NTHREADS + tid; idx < 64 * 2 * 1024; idx += G * NTHREADS) {
            const int pm = idx >> 11, side = (idx >> 10) & 1, ch = (idx & 1023) * 4;
            if (side == 0 ? (pm & 31) == 0 : (pm & 31) == 31) continue;
            const size_t eo = ((size_t)pm * 2 + side) * 4096 + ch;
            const f32x4 p = *(const f32x4*)(PP + 2 * eo), cv = *(const f32x4*)(PP + 2 * eo + 4);
            const f32x4 yn = side == 0 ? *(const f32x4*)(YE + ((size_t)(pm - 1) * 2 + 1) * 4096 + ch) : *(const f32x4*)(YE + ((size_t)(pm + 1) * 2 + 0) * 4096 + ch);
            const f32x4 w = *(const f32x4*)(l1_conv_w + (side == 0 ? 0 : 8192) + ch);
            const f32x4 o = p * (cv + w * yn); u32x2 pk; pk.x = cvt_pk_bf16(o[0], o[1]); pk.y = cvt_pk_bf16(o[2], o[3]);
            *(u32x2*)(M1 + ((size_t)pm * 256 + (side ? 255 : 0)) * 4096 + ch) = pk;
        }
    PH_END(12)
    SEAM(12);

    PH_BEGIN(13)
        pg8::Gemm g{M1, WO1, DM, DM, DM, 0}; pg8::StaticOrder S; S.init(MLAT, DM, G, bx); EpiOut E{x, D0, out, MOD + 3 * 12288 + 8192};
        pg8::gemm_phase<EpiOut, pg8::StaticOrder>(lds, g, S, E);
    PH_END(13)
#undef IN
#undef SEAM
}

constexpr int NPHASES = 14;
extern "C" void kernel_launch(void* const* d_in, const int* in_sizes, int n_in, void* d_out, int out_size, void* d_ws, size_t ws_size, hipStream_t stream) {
    static int grid = 0;
    if (grid == 0) {
        if (n_in != 35 || in_sizes[0] != MLAT * DM || out_size != MLAT * DM || ws_size < WS_END) {
            fprintf(stderr, "kernel_launch: shape mismatch: n_in %d in0 %d out %d ws %zu (need %zu)\n", n_in, n_in > 0 ? in_sizes[0] : -1, out_size, ws_size, (size_t)WS_END); grid = -1; return; }
        int dev = 0, cus = 0, per_cu = 0;
        if (hipGetDevice(&dev) != hipSuccess || hipDeviceGetAttribute(&cus, hipDeviceAttributeMultiprocessorCount, dev) != hipSuccess) { grid = -1; return; }
        if (hipFuncSetAttribute((const void*)fwd_kernel, hipFuncAttributeMaxDynamicSharedMemorySize, LDS_BYTES) != hipSuccess) { fprintf(stderr, "kernel_launch: hipFuncSetAttribute failed\n"); grid = -1; return; }
        if (hipOccupancyMaxActiveBlocksPerMultiprocessor(&per_cu, (const void*)fwd_kernel, NTHREADS, LDS_BYTES) != hipSuccess || per_cu < 1)
            fprintf(stderr, "kernel_launch: occupancy query reports %d workgroups per CU\n", per_cu);
        (void)hipGetLastError();
        grid = cus;
    }
    if (grid < 0) return;
    if (hipMemsetAsync((char*)d_ws + WS_CTL, 0, CTL_ZERO_BYTES, stream) != hipSuccess) { fprintf(stderr, "kernel_launch: memset failed\n"); return; }
    Args a{};
    for (int i = 0; i < 35; ++i) a.in[i] = (const float*)d_in[i];
    a.out = (float*)d_out; a.ws = (unsigned char*)d_ws;
#if MK_ONE_LAUNCH
    a.ph_lo = 0; a.ph_hi = NPHASES;
    hipLaunchKernelGGL(fwd_kernel, dim3(grid), dim3(NTHREADS), LDS_BYTES, stream, a);
#else
    for (int ph = 0; ph < NPHASES; ++ph) { a.ph_lo = ph; a.ph_hi = ph + 1; hipLaunchKernelGGL(fwd_kernel, dim3(grid), dim3(NTHREADS), LDS_BYTES, stream, a); }
#endif
    const hipError_t le = hipPeekAtLastError();
    if (le != hipSuccess) fprintf(stderr, "kernel_launch: launch failed: %s\n", hipGetErrorName(le));
}
```

```cpp
#include <hip/hip_runtime.h>
#include <hip/hip_bf16.h>
#include <cstdio>
#include <cstdint>

#ifndef ATT_PROBE
#define ATT_PROBE 0
#endif
#ifndef MK_ONE_LAUNCH
#define MK_ONE_LAUNCH 1
#endif

#define GAS __attribute__((address_space(1)))
#define LAS __attribute__((address_space(3)))
typedef unsigned short bf16_t;
typedef short bf16x8 __attribute__((ext_vector_type(8)));
typedef float f32x4 __attribute__((ext_vector_type(4)));
typedef float f32x2 __attribute__((ext_vector_type(2)));
typedef unsigned u32x4 __attribute__((ext_vector_type(4)));
typedef unsigned u32x2 __attribute__((ext_vector_type(2)));

constexpr int DM = 4096, NBATCH = 2, SEQ = 8192, CTXL = 256;
constexpr int MLAT = NBATCH * SEQ, MCTX = NBATCH * CTXL, MALL = MLAT + MCTX;
constexpr int NIN0 = 9216, NIN1 = 16384, SKV = SEQ + CTXL;
constexpr int NGRP = 128, NST = 64, GCH = 16, TCH = 32, NCHUNK = SEQ / TCH;
constexpr float EPS = 1e-6f;
constexpr float QK_LOG2_SCALE = 0.088388347648318440f * 1.4426950408889634f;
constexpr int NWAVES = 8, NTHREADS = 512;

__device__ __forceinline__ unsigned cvt_pk_bf16(float lo, float hi) { unsigned r; asm volatile("v_cvt_pk_bf16_f32 %0, %1, %2" : "=v"(r) : "v"(lo), "v"(hi)); return r; }
__device__ __forceinline__ float bf_lo(unsigned w) { return __uint_as_float(w << 16); }
__device__ __forceinline__ float bf_hi(unsigned w) { return __uint_as_float(w & 0xffff0000u); }
__device__ __forceinline__ float sigmoidf_(float x) { return __builtin_amdgcn_rcpf(1.0f + __builtin_amdgcn_exp2f(-1.4426950408889634f * x)); }
__device__ __forceinline__ float siluf_(float x) { return x * sigmoidf_(x); }
__device__ __forceinline__ float gelu_tanh_(float y) { const float z = 1.5957691216057308f * (y + 0.044715f * y * y * y); return y * sigmoidf_(z); }
#define LDS_WAIT() asm volatile("s_waitcnt lgkmcnt(0)" ::: "memory")
#define VM_WAIT() asm volatile("s_waitcnt vmcnt(0)" ::: "memory")

namespace pg8 {
constexpr int BM = 256, BK = 64, HALF = 128, HTB = HALF * BK * 2, STAGE_BYTES = 8 * HTB, NXCD = 8, WGM = 8;
__host__ __device__ __forceinline__ int lds_byte(int r, int c) { const int st = (r >> 4) * 2 + (c >> 5), rr = r & 15, cc = c & 31, ob = rr * 64 + cc * 2; return st * 1024 + (ob ^ (((ob >> 9) & 1) << 5)); }
__host__ __device__ __forceinline__ void stage_rc(int b, int& R, int& C) { const int st = b / 1024, sb = b % 1024, swz = sb ^ (((sb >> 9) & 1) << 5); R = (st >> 1) * 16 + swz / 64; C = (st & 1) * 32 + (swz % 64) / 2; }
__host__ __device__ __forceinline__ int perm32(int rho) { const int n = rho >> 4, i = rho & 15; return 8 * (i >> 2) + 4 * n + (i & 3); }

struct Unit { int pm, pn; };
struct Gemm { const bf16_t* A; const bf16_t* Bt; int lda, ldb, K, nt8; };

struct StaticOrder {
    int nM, nN, nwg, G, c;
    __host__ __device__ void init(int M, int N, int G_, int c_) { nM = M / BM; nN = N / BM; nwg = nM * nN; G = G_; c = c_; }
    __host__ __device__ bool next(int i, Unit& u) const {
        const long L = (long)i * G + c; if (L >= nwg) return false;
        int wgid = (int)L; { const int q = nwg / NXCD, r = nwg % NXCD, xcd = wgid % NXCD, off = wgid / NXCD; wgid = (xcd < r ? xcd * (q + 1) : r * (q + 1) + (xcd - r) * q) + off; }
        const int nig = WGM * nN, gid = wgid / nig, fm = gid * WGM, gsz = (nM - fm) < WGM ? (nM - fm) : WGM;
        u.pm = fm + ((wgid % nig) % gsz); u.pn = (wgid % nig) / gsz; return true;
    }
};

typedef int v4i_t __attribute__((ext_vector_type(4)));
typedef int v8i_t __attribute__((ext_vector_type(8)));
__device__ __forceinline__ v8i_t cat8(bf16x8 lo, bf16x8 hi) { const v4i_t a = __builtin_bit_cast(v4i_t, lo), b = __builtin_bit_cast(v4i_t, hi); return __builtin_shufflevector(a, b, 0, 1, 2, 3, 4, 5, 6, 7); }
template <class Epi, class Sched, int MODE = 0>
__device__ __forceinline__ void gemm_phase(LAS unsigned char* lds, const Gemm g, const Sched& S, const Epi& E) {
    const int tid = threadIdx.x, wid = __builtin_amdgcn_readfirstlane(tid >> 6), lane = tid & 63, wr = wid >> 2, wc = wid & 3, fr = lane & 15, fq = lane >> 4;
    constexpr bool FP8 = MODE == 1; const int K = g.K, nt = FP8 ? K / 128 : K / BK;
    unsigned voffA[2], voffB[2];
#pragma unroll
    for (int i = 0; i < 2; ++i) { int R, C; stage_rc(tid * 16 + i * 8192, R, C); const int Rb = Epi::PERM ? ((R & ~31) + perm32(R & 31)) : R;
        voffA[i] = (unsigned)(R * g.lda + C) * 2u; voffB[i] = (unsigned)(Rb * g.ldb + C) * 2u; }
    const size_t kstep = (size_t)(BK * 2);
    const size_t hstepA = (size_t)HALF * g.lda * 2, hstepB = (size_t)HALF * g.ldb * 2;
    const size_t tstepA = 2 * hstepA, tstepB = 2 * hstepB;
    const unsigned ldsw = (unsigned)wid * 1024u;
    const int aoff = lds_byte(wr * 64 + fr, fq * 8), boff = lds_byte(wc * 32 + fr, fq * 8);
#define PG8_SA(b, h) (((b) * 2 + (h)) * HTB)
#define PG8_SB(b, h) ((4 + (b) * 2 + (h)) * HTB)
#define PG8_STAGE(bufoff, gbase, voff) do { _Pragma("unroll") for (int _i = 0; _i < 2; ++_i) \
        __builtin_amdgcn_global_load_lds((const unsigned*)((const char*)(gbase) + (voff)[_i]), (LAS unsigned*)(lds + (bufoff) + ldsw + _i * 8192), 16, 0, 0); } while (0)
#define PG8_LD32(p) __builtin_shufflevector(*(const LAS v4i_t*)(p), *(const LAS v4i_t*)((p) + 1024), 0, 1, 2, 3, 4, 5, 6, 7)
#define PG8_LDA0(dst, b, h) do { _Pragma("unroll") for (int m = 0; m < 4; ++m) _Pragma("unroll") for (int k = 0; k < 2; ++k) dst[m][k] = *(const LAS bf16x8*)(lds + PG8_SA(b, h) + aoff + m * 2048 + k * 1024); } while (0)
#define PG8_LDB0(dst, b, h) do { _Pragma("unroll") for (int n = 0; n < 2; ++n) _Pragma("unroll") for (int k = 0; k < 2; ++k) dst[n][k] = *(const LAS bf16x8*)(lds + PG8_SB(b, h) + boff + n * 2048 + k * 1024); } while (0)
#define PG8_LDA1(dst, b, h) do { _Pragma("unroll") for (int m = 0; m < 4; ++m) dst##8[m] = PG8_LD32(lds + PG8_SA(b, h) + aoff + m * 2048); } while (0)
#define PG8_LDB1(dst, b, h) do { _Pragma("unroll") for (int n = 0; n < 2; ++n) dst##8[n] = PG8_LD32(lds + PG8_SB(b, h) + boff + n * 2048); } while (0)
#define PG8_MMA0(ai, bj, At, Bt) do { __builtin_amdgcn_s_setprio(1); _Pragma("unroll") for (int m = 0; m < 4; ++m) _Pragma("unroll") for (int n = 0; n < 2; ++n) _Pragma("unroll") for (int k = 0; k < 2; ++k) \
        acc[ai][bj][m][n] = __builtin_amdgcn_mfma_f32_16x16x32_bf16(Bt[n][k], At[m][k], acc[ai][bj][m][n], 0, 0, 0); __builtin_amdgcn_s_setprio(0); } while (0)
#define PG8_MMA1(ai, bj, At, Bt) do { __builtin_amdgcn_s_setprio(1); _Pragma("unroll") for (int m = 0; m < 4; ++m) _Pragma("unroll") for (int n = 0; n < 2; ++n) \
        asm volatile("v_mfma_f32_16x16x128_f8f6f4 %0, %1, %2, %0" : "+v"(acc[ai][bj][m][n]) : "v"(Bt##8[n]), "v"(At##8[m])); __builtin_amdgcn_s_setprio(0); } while (0)
#define PG8_MMA1S(ai, bj, At, Bt) do { __builtin_amdgcn_s_setprio(1); _Pragma("unroll") for (int m = 0; m < 4; ++m) _Pragma("unroll") for (int n = 0; n < 2; ++n) \
        asm volatile("v_mfma_scale_f32_16x16x128_f8f6f4 %0, %1, %2, %0, %3, %4 op_sel_hi:[0,0,0]" : "+v"(acc[ai][bj][m][n]) : "v"(Bt##8[n]), "v"(At##8[m]), "v"(sclw), "v"(scla)); __builtin_amdgcn_s_setprio(0); } while (0)
#define PG8_KBODY(LA, LB, MM) { \
            const bool last = (t == nt - 2); \
            const char* a1 = cA + (size_t)(t + 1) * kstep; \
            const char* a2 = last ? nA : cA + (size_t)(t + 2) * kstep; const char* b2 = last ? nB : cB + (size_t)(t + 2) * kstep; \
            const char* a3 = a2 + kstep; const char* b3 = b2 + kstep; \
            LB(B0, 0, 0); LB(B1, 0, 1); PG8_SCHED; LA(At, 0, 0); PG8_STAGE(PG8_SA(1, 1), a1 + hstepA, voffA); \
            PG8_WAIT_V(8); PG8_WAIT_L(0); PG8_BAR; MM(0, 0, At, B0); MM(0, 1, At, B1); PG8_BAR; PG8_SCHED; \
            LA(At, 0, 1); PG8_STAGE(PG8_SB(0, 0), b2, voffB); PG8_STAGE(PG8_SB(0, 1), b2 + hstepB, voffB); PG8_STAGE(PG8_SA(0, 0), a2, voffA); \
            PG8_WAIT_V(8); PG8_WAIT_L(0); PG8_BAR; MM(1, 0, At, B0); MM(1, 1, At, B1); PG8_BAR; PG8_SCHED; \
            LB(B0, 1, 0); LB(B1, 1, 1); PG8_SCHED; LA(At, 1, 0); PG8_STAGE(PG8_SA(0, 1), a2 + hstepA, voffA); \
            PG8_WAIT_V(8); PG8_WAIT_L(0); PG8_BAR; MM(0, 0, At, B0); MM(0, 1, At, B1); PG8_BAR; PG8_SCHED; \
            LA(At, 1, 1); PG8_STAGE(PG8_SB(1, 0), b3, voffB); PG8_STAGE(PG8_SB(1, 1), b3 + hstepB, voffB); PG8_STAGE(PG8_SA(1, 0), a3, voffA); \
            PG8_WAIT_V(8); PG8_WAIT_L(0); PG8_BAR; MM(1, 0, At, B0); MM(1, 1, At, B1); PG8_BAR; PG8_SCHED; }
#define PG8_WAIT_V(n) asm volatile("s_waitcnt vmcnt(" #n ")" ::: "memory")
#define PG8_WAIT_L(n) asm volatile("s_waitcnt lgkmcnt(" #n ")" ::: "memory")
#define PG8_BAR __builtin_amdgcn_s_barrier()
#define PG8_SCHED __builtin_amdgcn_sched_barrier(0)
    Unit cur, nxt; int ui = 0;
    if (!S.next(0, cur)) return;
    f32x4 acc[2][2][4][2];
#pragma unroll
    for (int a = 0; a < 2; ++a)
#pragma unroll
        for (int b = 0; b < 2; ++b)
#pragma unroll
            for (int m = 0; m < 4; ++m)
#pragma unroll
                for (int n = 0; n < 2; ++n) acc[a][b][m][n] = (f32x4){0.f, 0.f, 0.f, 0.f};
    int sclw = 119, scla = 124; asm volatile("" : "+v"(sclw), "+v"(scla));
    bf16x8 At[4][2], B0[2][2], B1[2][2]; v8i_t At8[4], B08[2], B18[2];
    const char* cA = (const char*)g.A + (size_t)cur.pm * tstepA; const char* cB = (const char*)g.Bt + (size_t)cur.pn * tstepB;
    PG8_STAGE(PG8_SB(0, 0), cB, voffB); PG8_STAGE(PG8_SB(0, 1), cB + hstepB, voffB); PG8_STAGE(PG8_SA(0, 0), cA, voffA); PG8_STAGE(PG8_SA(0, 1), cA + hstepA, voffA);
    if (wr == 1) PG8_BAR;
    PG8_WAIT_V(2); PG8_BAR;
    PG8_STAGE(PG8_SB(1, 0), cB + kstep, voffB); PG8_STAGE(PG8_SA(1, 0), cA + kstep, voffA); PG8_STAGE(PG8_SB(1, 1), cB + hstepB + kstep, voffB);
    PG8_WAIT_V(6); PG8_BAR;
    for (;;) {
        const bool has_next = S.next(ui + 1, nxt);
        const char* nA = has_next ? (const char*)g.A + (size_t)nxt.pm * tstepA : cA; const char* nB = has_next ? (const char*)g.Bt + (size_t)nxt.pn * tstepB : cB;
        if constexpr (MODE == 2) {
            int t = 0;
            for (; t < g.nt8; t += 2) PG8_KBODY(PG8_LDA1, PG8_LDB1, PG8_MMA1S)
            for (; t < nt; t += 2) PG8_KBODY(PG8_LDA0, PG8_LDB0, PG8_MMA0)
        } else if constexpr (MODE == 1) {
            for (int t = 0; t < nt; t += 2) PG8_KBODY(PG8_LDA1, PG8_LDB1, PG8_MMA1)
        } else {
            for (int t = 0; t < nt; t += 2) PG8_KBODY(PG8_LDA0, PG8_LDB0, PG8_MMA0)
        }
        if (wr == 0) PG8_BAR;
        if constexpr (MODE == 2) asm volatile("s_nop 15\n\ts_nop 15\n\ts_nop 15" ::: "memory");
        if constexpr (FP8) {
            asm volatile("s_nop 15\n\ts_nop 15\n\ts_nop 15" ::: "memory");
#pragma unroll
            for (int a = 0; a < 2; ++a)
#pragma unroll
                for (int b = 0; b < 2; ++b)
#pragma unroll
                    for (int m = 0; m < 4; ++m)
#pragma unroll
                        for (int n = 0; n < 2; ++n) acc[a][b][m][n] *= (1.0f / 256.0f); }
        { int lane_o = lane; asm volatile("" : "+v"(lane_o)); E(acc, cur, wr, wc, lane_o & 15, lane_o >> 4); }
        if (!has_next) break;
#pragma unroll
        for (int a = 0; a < 2; ++a)
#pragma unroll
            for (int b = 0; b < 2; ++b)
#pragma unroll
                for (int m = 0; m < 4; ++m)
#pragma unroll
                    for (int n = 0; n < 2; ++n) acc[a][b][m][n] = (f32x4){0.f, 0.f, 0.f, 0.f};
        cur = nxt; cA = nA; cB = nB; ++ui;
        if (wr == 1) PG8_BAR;
    }
    PG8_WAIT_V(0);
    PG8_BAR;
#undef PG8_SA
#undef PG8_SB
#undef PG8_STAGE
#undef PG8_LDA0
#undef PG8_LDA1
#undef PG8_LDB0
#undef PG8_LDB1
#undef PG8_MMA0
#undef PG8_MMA1
#undef PG8_MMA1S
#undef PG8_KBODY
#undef PG8_LD32
#undef PG8_WAIT_V
#undef PG8_WAIT_L
#undef PG8_BAR
#undef PG8_SCHED
}
}

constexpr size_t MiB = 1u << 20;
constexpr size_t WS_CTL = 0, CTL_ZERO_BYTES = 1 * MiB;
constexpr size_t WS_MOD = 1 * MiB;
constexpr size_t WS_SSMP = 2 * MiB;
constexpr size_t SSMP_A1 = 0, SSMP_A32 = 131072, SSMP_BB = 262144;
constexpr size_t WS_ROPE = 5 * MiB;
constexpr size_t WS_YE = 6 * MiB;
constexpr size_t WS_PP = 8 * MiB;
constexpr size_t WS_UCTX = 12 * MiB;
constexpr size_t WS_BT0 = 14 * MiB;
constexpr size_t WS_WGT = WS_BT0 + 72 * MiB;
constexpr size_t WS_WO0 = WS_WGT + 8 * MiB;
constexpr size_t WS_BT1 = WS_WO0 + 32 * MiB;
constexpr size_t WS_WO1 = WS_BT1 + 128 * MiB;
constexpr size_t WS_PT = WS_WO1 + 32 * MiB;
constexpr size_t WS_KMT = WS_PT + 32 * MiB;
constexpr size_t WS_XN = WS_KMT + 96 * MiB;
constexpr size_t WS_Q = WS_XN + 132 * MiB;
constexpr size_t WS_K = WS_Q + 64 * MiB;
constexpr size_t WS_V = WS_K + 17 * MiB;
constexpr size_t WS_GA = WS_V + 17 * MiB;
constexpr size_t WS_GS = WS_GA + 64 * MiB;
constexpr size_t WS_M1 = WS_GA;
constexpr size_t WS_AS = WS_GS + 64 * MiB;
constexpr size_t WS_YG = WS_AS + 96 * MiB;
constexpr size_t WS_MIX = WS_YG + 64 * MiB;
constexpr size_t WS_D0 = WS_AS;
constexpr size_t WS_S = WS_MIX;
constexpr size_t WS_END = WS_MIX + 128 * MiB;
constexpr int CW_TMO = 0, CW_QCTR = 64, CW_BAR = 4096;

constexpr int RING_BYTES = 131072, TRSCR_BYTES = 8 * 16640  , EPI_OFF = TRSCR_BYTES, LDSCTL_OFF = EPI_OFF + 8192, LDS_BYTES = 147456;
static_assert(LDSCTL_OFF + 512 <= LDS_BYTES, "LDS map");

#define XB_TMO      128
#define XB_XCNT(j)  (256  + 64 * (j))
#define XB_XSUB(j)  (1280 + 64 * (j))
#define XB_XGEN(j)  (2304 + 64 * (j))
#define XB_TOP      3328
#define XB_TOPGEN   3392
#define XCD_BAR_WORDS 3456
#define XB_SPIN_CAP (1u << 18)
__device__ __forceinline__ unsigned xb_ld(unsigned* p)              { return __hip_atomic_load(p, __ATOMIC_RELAXED, __HIP_MEMORY_SCOPE_AGENT); }
__device__ __forceinline__ unsigned xb_add(unsigned* p, unsigned v) { return __hip_atomic_fetch_add(p, v, __ATOMIC_RELAXED, __HIP_MEMORY_SCOPE_AGENT); }
__device__ __forceinline__ unsigned xb_xcc_id() { return (unsigned)__builtin_amdgcn_s_getreg((3 << 11) | 20) & 0xFu; }
#define XB_SPIN(cond, bar) do { unsigned _sp = 0; while (cond) { __builtin_amdgcn_s_sleep(1); \
    if ((++_sp & 255u) == 0u) { if (xb_ld(&(bar)[XB_TMO])) break; if (_sp > XB_SPIN_CAP) { atomicAdd(&(bar)[XB_TMO], 1u); break; } } } } while (0)
struct XcdBarrier { unsigned* bar; unsigned x; volatile LAS unsigned* st; };
__device__ __forceinline__ XcdBarrier xcd_barrier_post(unsigned* bar, volatile LAS unsigned* st) {
    XcdBarrier b; b.bar = bar; b.x = xb_xcc_id(); b.st = st;
    if (threadIdx.x == 0) (void)xb_add(&bar[XB_XCNT(b.x)], 1u);
    return b;
}
__device__ __forceinline__ void xcd_barrier_complete(unsigned* bar, unsigned x, unsigned& nloc, unsigned& nx) {
    const unsigned G = gridDim.x * gridDim.y * gridDim.z;
    unsigned sum, cnt, mine, sp = 0u;
    for (;;) {
        sum = 0u; cnt = 0u; mine = 0u;
#pragma unroll
        for (unsigned j = 0; j < 16; ++j) { const unsigned c = xb_ld(&bar[XB_XCNT(j)]); sum += c; cnt += (c > 0u) ? 1u : 0u; mine = (j == x) ? c : mine; }
        if (sum == G) break;
        __builtin_amdgcn_s_sleep(1);
        if ((++sp & 255u) == 0u) { if (xb_ld(&bar[XB_TMO])) break; if (sp > XB_SPIN_CAP) { atomicAdd(&bar[XB_TMO], 1u); break; } }
    }
    nloc = mine > 0u ? mine : 1u; nx = cnt > 0u ? cnt : 1u;
}
__device__ __forceinline__ void xcd_barrier(const XcdBarrier& b) {
    asm volatile("s_waitcnt vmcnt(0)" ::: "memory");
    __syncthreads();
    if (threadIdx.x == 0) {
        unsigned* bar = b.bar;
        __builtin_amdgcn_s_waitcnt(0);
        unsigned nloc = b.st[0], nx = b.st[1];
        if (nloc == 0u) { xcd_barrier_complete(bar, b.x, nloc, nx); b.st[0] = nloc; b.st[1] = nx; }
        const unsigned old = xb_add(&bar[XB_XSUB(b.x)], 1u);
        const unsigned gen = old / nloc;
        if (old + 1u == (gen + 1u) * nloc) {
            __builtin_amdgcn_fence(__ATOMIC_RELEASE, "agent");
            asm volatile("s_waitcnt vmcnt(0)" ::: "memory");
            const unsigned og = xb_add(&bar[XB_TOP], 1u);
            const unsigned tg = og / nx;
            if (og + 1u == (tg + 1u) * nx) xb_add(&bar[XB_TOPGEN], 1u);
            else XB_SPIN(xb_ld(&bar[XB_TOPGEN]) == tg, bar);
            __builtin_amdgcn_fence(__ATOMIC_ACQUIRE, "agent");
            xb_add(&bar[XB_XGEN(b.x)], 1u);
            asm volatile("s_waitcnt vmcnt(0)" ::: "memory");
        } else {
            XB_SPIN(xb_ld(&bar[XB_XGEN(b.x)]) == gen, bar);
            __builtin_amdgcn_fence(__ATOMIC_ACQUIRE, "agent");
            asm volatile("s_waitcnt vmcnt(0)" ::: "memory");
        }
    }
    __syncthreads();
}

struct Args {
    const float* in[35];
    float* out; unsigned char* ws;
    int ph_lo, ph_hi;
};

__host__ __device__ __forceinline__ int vt_pos(int k) { const int blk = k >> 5, k5 = k & 31, hi = (k5 >> 2) & 1, r = (k5 & 3) + 4 * (k5 >> 3); return 32 * hi + r + 16 * blk; }
__device__ __forceinline__ u32x4 pack8(const f32x4 a, const f32x4 b) { u32x4 w; w.x = cvt_pk_bf16(a[0], a[1]); w.y = cvt_pk_bf16(a[2], a[3]); w.z = cvt_pk_bf16(b[0], b[1]); w.w = cvt_pk_bf16(b[2], b[3]); return w; }

struct EpiIn0 {
    static constexpr bool PERM = true;
    bf16_t *Q, *K, *V, *GA, *GS, *AS, *UC; const float *qw, *kw, *ropec, *ropes; LAS float* P; unsigned char *Q8, *K8, *V8T;
    __device__ __forceinline__ void operator()(const f32x4 (&acc)[2][2][4][2], const pg8::Unit& u, int wr, int wc, int fr, int fq) const {
        const int pn = u.pn, pm = u.pm; const bool ctx = pm >= 64;
        const int cb = 32 * wc + 8 * fq;
        if (pn < 10) {
            const bool isq = pn < 8;
#pragma unroll
            for (int ai = 0; ai < 2; ++ai)
#pragma unroll
                for (int m = 0; m < 4; ++m)
#pragma unroll
                    for (int bj = 0; bj < 2; ++bj) { const f32x4 a = acc[ai][bj][m][0], b = acc[ai][bj][m][1];
                        float s = (a[0] * a[0] + a[1] * a[1]) + (a[2] * a[2] + a[3] * a[3]) + (b[0] * b[0] + b[1] * b[1]) + (b[2] * b[2] + b[3] * b[3]);
                        s += __shfl_xor(s, 16); s += __shfl_xor(s, 32);
                        if (fq == 0) P[(ai * 128 + wr * 64 + m * 16 + fr) * 8 + bj * 4 + wc] = s; }
            LDS_WAIT(); __builtin_amdgcn_s_barrier(); asm volatile("" ::: "memory");
            const float* nw = isq ? qw : kw; const int axis = wc >> 1, fbase = (wc & 1) * 16 + 4 * fq, dbase = axis * 64 + fbase;
            const f32x4 w0 = *(const f32x4*)(nw + dbase), w1 = *(const f32x4*)(nw + dbase + 32);
#pragma unroll
            for (int ai = 0; ai < 2; ++ai)
#pragma unroll
                for (int m = 0; m < 4; ++m) { const int rl = ai * 128 + wr * 64 + m * 16 + fr, row = pm * 256 + rl, t = row & (SEQ - 1), b = row >> 13;
                    f32x4 c4 = (f32x4){1.f, 1.f, 1.f, 1.f}, s4 = (f32x4){0.f, 0.f, 0.f, 0.f};
                    if (!ctx) { const int pos = axis ? (t & 63) : (t >> 6); c4 = *(const f32x4*)(ropec + pos * 32 + fbase); s4 = *(const f32x4*)(ropes + pos * 32 + fbase); }
                    bf16_t* dst;
                    unsigned char* dst8;
                    if (isq) { dst = Q + (size_t)row * 2048 + pn * 256 + cb; dst8 = Q8 + (size_t)row * 2048 + pn * 256 + cb; }
                    else { const size_t krow = ctx ? (size_t)(pm - 64) * SKV + rl : (size_t)b * SKV + CTXL + t; dst = K + krow * 512 + (pn - 8) * 256 + cb; dst8 = K8 + krow * 512 + (pn - 8) * 256 + cb; }
#pragma unroll
                    for (int bj = 0; bj < 2; ++bj) { const f32x4 ps = *(const LAS f32x4*)(P + rl * 8 + bj * 4);
                        const float rstd = __builtin_amdgcn_rsqf(((ps[0] + ps[1]) + (ps[2] + ps[3])) * (1.0f / 128.0f) + EPS);
                        const f32x4 x1 = acc[ai][bj][m][0] * rstd * w0, x2 = acc[ai][bj][m][1] * rstd * w1;
                        const f32x4 o1 = x1 * c4 - x2 * s4, o2 = x2 * c4 + x1 * s4;
                        if (ATT_PROBE) *(u32x4*)(dst + bj * 128) = pack8(o1, o2);
                        { u32x2 w8; const float qs = isq ? QK_LOG2_SCALE : 1.0f; const f32x4 e1 = o1 * qs, e2 = o2 * qs;
                          int tq = __builtin_amdgcn_cvt_pk_fp8_f32(e1[0], e1[1], 0, false); tq = __builtin_amdgcn_cvt_pk_fp8_f32(e1[2], e1[3], tq, true); w8.x = (unsigned)tq;
                          tq = __builtin_amdgcn_cvt_pk_fp8_f32(e2[0], e2[1], 0, false); tq = __builtin_amdgcn_cvt_pk_fp8_f32(e2[2], e2[3], tq, true); w8.y = (unsigned)tq;
                          *(u32x2*)(dst8 + bj * 128) = w8; } } }
            return;
        }
        const int mode = pn < 12 ? 0 : (pn < 20 ? 1 : (pn < 28 ? 2 : 3));
#pragma unroll
        for (int ai = 0; ai < 2; ++ai)
#pragma unroll
            for (int m = 0; m < 4; ++m) { const int rl = ai * 128 + wr * 64 + m * 16 + fr, row = pm * 256 + rl, t = row & (SEQ - 1), b = row >> 13;
#pragma unroll
                for (int bj = 0; bj < 2; ++bj) { f32x4 a = acc[ai][bj][m][0], c = acc[ai][bj][m][1]; bf16_t* dst;
                    if (mode == 0) { const int kk = ctx ? rl : CTXL + t, bb = ctx ? pm - 64 : b, vcol = (pn - 10) * 256 + bj * 128 + cb;
                        unsigned char* vt = V8T + ((size_t)(bb * 4 + (vcol >> 7)) * 128 + (vcol & 127)) * SKV + (kk & ~63) + vt_pos(kk & 63);
                        const int w0 = __builtin_amdgcn_cvt_pk_fp8_f32(a[0], a[1], 0, false), w1 = __builtin_amdgcn_cvt_pk_fp8_f32(a[2], a[3], 0, false);
                        const int w2 = __builtin_amdgcn_cvt_pk_fp8_f32(c[0], c[1], 0, false), w3 = __builtin_amdgcn_cvt_pk_fp8_f32(c[2], c[3], 0, false);
                        vt[0] = (unsigned char)w0; vt[SKV] = (unsigned char)(w0 >> 8); vt[2 * SKV] = (unsigned char)w1; vt[3 * SKV] = (unsigned char)(w1 >> 8);
                        vt[4 * SKV] = (unsigned char)w2; vt[5 * SKV] = (unsigned char)(w2 >> 8); vt[6 * SKV] = (unsigned char)w3; vt[7 * SKV] = (unsigned char)(w3 >> 8);
                        if (!ATT_PROBE) continue;
                        const size_t krow = ctx ? (size_t)(pm - 64) * SKV + rl : (size_t)b * SKV + CTXL + t; dst = V + krow * 512 + (pn - 10) * 256 + bj * 128 + cb; }
                    else if (mode == 2) { const int gcol = (pn - 20) * 256 + bj * 128 + cb, g = gcol >> 4, j0 = gcol & 15;
                        dst = ctx ? UC + ((size_t)((pm - 64) * NGRP + g) * CTXL + rl) * 16 + j0 : AS + ((size_t)((b * NGRP + g) * NCHUNK) + (t >> 5)) * 768 + (t & 31) * 16 + j0; }
                    else { bf16_t* base = mode == 1 ? GA : GS; const int c0 = (mode == 1 ? pn - 12 : pn - 28) * 256 + bj * 128 + cb; dst = base + (size_t)row * 2048 + c0;
#pragma unroll
                        for (int e = 0; e < 4; ++e) { a[e] = siluf_(a[e]); c[e] = siluf_(c[e]); } }
                    *(u32x4*)dst = pack8(a, c); } }
    }
};
struct EpiS {
    static constexpr bool PERM = true;
    float* S;
    __device__ __forceinline__ void operator()(const f32x4 (&acc)[2][2][4][2], const pg8::Unit& u, int wr, int wc, int fr, int fq) const {
#pragma unroll
        for (int ai = 0; ai < 2; ++ai)
#pragma unroll
            for (int m = 0; m < 4; ++m) { float* rp = S + ((size_t)u.pm * 256 + ai * 128 + wr * 64 + m * 16 + fr) * 256 + wc * 32 + 8 * fq;
#pragma unroll
                for (int bj = 0; bj < 2; ++bj)
#pragma unroll
                    for (int n = 0; n < 2; ++n) *(f32x4*)(rp + bj * 128 + n * 4) = acc[ai][bj][m][n]; }
    }
};
struct EpiY {
    static constexpr bool PERM = true;
    bf16_t* YG; unsigned char* YG8;
    __device__ __forceinline__ void operator()(const f32x4 (&acc)[2][2][4][2], const pg8::Unit& u, int wr, int wc, int fr, int fq) const {
        const int b = u.pm >> 7, g = u.pm & 127, half = u.pn & 1;
#pragma unroll
        for (int ai = 0; ai < 2; ++ai)
#pragma unroll
            for (int m = 0; m < 4; ++m) { const int ch = ai * 128 + wr * 64 + m * 16 + fr;
#pragma unroll
                for (int bj = 0; bj < 2; ++bj) { const int ncol = half * 256 + bj * 128 + wc * 32 + 8 * fq, tau = ncol >> 4, i0 = ncol & 15;
                    f32x4 a = acc[ai][bj][m][0], c = acc[ai][bj][m][1];
#pragma unroll
                    for (int e = 0; e < 4; ++e) { a[e] = gelu_tanh_(a[e]); c[e] = gelu_tanh_(c[e]); }
                    const size_t yo = ((size_t)b * SEQ + ch * 32 + tau) * 2048 + g * 16 + i0;
                    *(u32x4*)(YG + yo) = pack8(a, c);
                    { u32x2 w8; a = a * 8.f; c = c * 8.f;
#pragma unroll
                      for (int e = 0; e < 4; ++e) { a[e] = __builtin_fminf(__builtin_fmaxf(a[e], -448.f), 448.f); c[e] = __builtin_fminf(__builtin_fmaxf(c[e], -448.f), 448.f); }
                      int t = __builtin_amdgcn_cvt_pk_fp8_f32(a[0], a[1], 0, false); t = __builtin_amdgcn_cvt_pk_fp8_f32(a[2], a[3], t, true); w8.x = (unsigned)t;
                      t = __builtin_amdgcn_cvt_pk_fp8_f32(c[0], c[1], 0, false); t = __builtin_amdgcn_cvt_pk_fp8_f32(c[2], c[3], t, true); w8.y = (unsigned)t;
                      *(u32x2*)(YG8 + yo) = w8; } } }
    }
};
struct EpiGlu {
    static constexpr bool PERM = true;
    const bf16_t *YG, *GS; const float* bglu; bf16_t* MIX;
    __device__ __forceinline__ void operator()(const f32x4 (&acc)[2][2][4][2], const pg8::Unit& u, int wr, int wc, int fr, int fq) const {
#pragma unroll
        for (int bj = 0; bj < 2; ++bj) { const int col = u.pn * 256 + bj * 128 + wc * 32 + 8 * fq;
            const f32x4 b0 = *(const f32x4*)(bglu + col), b1 = *(const f32x4*)(bglu + col + 4);
#pragma unroll
            for (int ai = 0; ai < 2; ++ai)
#pragma unroll
                for (int m = 0; m < 4; ++m) { const size_t row = (size_t)u.pm * 256 + ai * 128 + wr * 64 + m * 16 + fr;
                    const u32x4 y = *(const u32x4*)(YG + row * 2048 + col), gs = *(const u32x4*)(GS + row * 2048 + col);
                    const f32x4 a = acc[ai][bj][m][0] + b0, c = acc[ai][bj][m][1] + b1; f32x4 o0, o1;
                    o0[0] = bf_lo(y.x) * sigmoidf_(a[0]) * bf_lo(gs.x); o0[1] = bf_hi(y.x) * sigmoidf_(a[1]) * bf_hi(gs.x);
                    o0[2] = bf_lo(y.y) * sigmoidf_(a[2]) * bf_lo(gs.y); o0[3] = bf_hi(y.y) * sigmoidf_(a[3]) * bf_hi(gs.y);
                    o1[0] = bf_lo(y.z) * sigmoidf_(c[0]) * bf_lo(gs.z); o1[1] = bf_hi(y.z) * sigmoidf_(c[1]) * bf_hi(gs.z);
                    o1[2] = bf_lo(y.w) * sigmoidf_(c[2]) * bf_lo(gs.w); o1[3] = bf_hi(y.w) * sigmoidf_(c[3]) * bf_hi(gs.w);
                    *(u32x4*)((unsigned char*)MIX + row * 6144 + 2048 + (size_t)col * 2) = pack8(o0, o1); } }
    }
};
struct EpiDelta {
    static constexpr bool PERM = true;
    bf16_t* D0; const float* gate;
    __device__ __forceinline__ void operator()(const f32x4 (&acc)[2][2][4][2], const pg8::Unit& u, int wr, int wc, int fr, int fq) const {
        const int b = u.pm >> 5;
#pragma unroll
        for (int bj = 0; bj < 2; ++bj) { const int col = u.pn * 256 + bj * 128 + wc * 32 + 8 * fq;
            const f32x4 g0 = *(const f32x4*)(gate + b * 12288 + col), g1 = *(const f32x4*)(gate + b * 12288 + col + 4);
#pragma unroll
            for (int ai = 0; ai < 2; ++ai)
#pragma unroll
                for (int m = 0; m < 4; ++m) { const size_t off = ((size_t)u.pm * 256 + ai * 128 + wr * 64 + m * 16 + fr) * 4096 + col;
                    *(u32x4*)(D0 + off) = pack8(g0 * acc[ai][bj][m][0], g1 * acc[ai][bj][m][1]); } }
    }
};
struct EpiOut {
    static constexpr bool PERM = true;
    const float* x; const bf16_t* D0; float* out; const float* gate;
    __device__ __forceinline__ void operator()(const f32x4 (&acc)[2][2][4][2], const pg8::Unit& u, int wr, int wc, int fr, int fq) const {
        const int b = u.pm >> 5;
#pragma unroll
        for (int bj = 0; bj < 2; ++bj) { const int col = u.pn * 256 + bj * 128 + wc * 32 + 8 * fq;
            const f32x4 g0 = *(const f32x4*)(gate + b * 12288 + col), g1 = *(const f32x4*)(gate + b * 12288 + col + 4);
#pragma unroll
            for (int ai = 0; ai < 2; ++ai)
#pragma unroll
                for (int m = 0; m < 4; ++m) { const size_t off = ((size_t)u.pm * 256 + ai * 128 + wr * 64 + m * 16 + fr) * 4096 + col;
                    const f32x4 r0 = *(const f32x4*)(x + off), r1 = *(const f32x4*)(x + off + 4); const u32x4 d = *(const u32x4*)(D0 + off);
                    f32x4 d0, d1; d0[0] = bf_lo(d.x); d0[1] = bf_hi(d.x); d0[2] = bf_lo(d.y); d0[3] = bf_hi(d.y); d1[0] = bf_lo(d.z); d1[1] = bf_hi(d.z); d1[2] = bf_lo(d.w); d1[3] = bf_hi(d.w);
                    *(f32x4*)(out + off) = (r0 + d0) + g0 * acc[ai][bj][m][0]; *(f32x4*)(out + off + 4) = (r1 + d1) + g1 * acc[ai][bj][m][1]; } }
    }
};
#define DPPF(old, src, ctrl) __int_as_float(__builtin_amdgcn_update_dpp(__float_as_int(old), __float_as_int(src), ctrl, 0xF, 0xF, false))
struct EpiConv {
    static constexpr bool PERM = false;
    bf16_t* M1; const float *cw, *cb; float *YE, *PP; LAS float* EB;
    __device__ __forceinline__ void operator()(const f32x4 (&acc)[2][2][4][2], const pg8::Unit& u, int wr, int wc, int fr, int fq) const {
        const int chl = 16 * wc + 4 * fq, ch = u.pn * 64 + chl;
        f32x4 y[2][4], eprev[2], enext[2];
#pragma unroll
        for (int ai = 0; ai < 2; ++ai)
#pragma unroll
            for (int m = 0; m < 4; ++m) y[ai][m] = acc[ai][0][m][1] * acc[ai][1][m][0];
#pragma unroll
        for (int ai = 0; ai < 2; ++ai) { const int run = 2 * ai + wr;
            if (fr == 0) *(LAS f32x4*)(EB + (run * 2 + 0) * 64 + chl) = y[ai][0];
            if (fr == 15) *(LAS f32x4*)(EB + (run * 2 + 1) * 64 + chl) = y[ai][3]; }
        LDS_WAIT(); __builtin_amdgcn_s_barrier(); asm volatile("" ::: "memory");
#pragma unroll
        for (int ai = 0; ai < 2; ++ai) { const int run = 2 * ai + wr;
            eprev[ai] = run > 0 ? *(const LAS f32x4*)(EB + ((run - 1) * 2 + 1) * 64 + chl) : (f32x4){0.f, 0.f, 0.f, 0.f};
            enext[ai] = run < 3 ? *(const LAS f32x4*)(EB + ((run + 1) * 2 + 0) * 64 + chl) : (f32x4){0.f, 0.f, 0.f, 0.f}; }
        const f32x4 w0 = *(const f32x4*)(cw + ch), w1 = *(const f32x4*)(cw + 4096 + ch), w2 = *(const f32x4*)(cw + 8192 + ch), bs = *(const f32x4*)(cb + ch);
#pragma unroll
        for (int ai = 0; ai < 2; ++ai)
#pragma unroll
            for (int m = 0; m < 4; ++m) { f32x4 yp, yn, p, cv;
#pragma unroll
                for (int e = 0; e < 4; ++e) {
                    const float wp = m > 0 ? DPPF(0.f, y[ai][m > 0 ? m - 1 : 0][e], 0x121) : eprev[ai][e];
                    const float wn = m < 3 ? DPPF(0.f, y[ai][m < 3 ? m + 1 : 3][e], 0x12F) : enext[ai][e];
                    yp[e] = DPPF(wp, y[ai][m][e], 0x111); yn[e] = DPPF(wn, y[ai][m][e], 0x101);
                    p[e] = acc[ai][0][m][0][e] * siluf_(acc[ai][1][m][1][e]); }
                cv = bs + w0 * yp + w1 * y[ai][m] + w2 * yn;
                const int rl = ai * 128 + wr * 64 + m * 16 + fr; const size_t row = (size_t)u.pm * 256 + rl;
                const f32x4 o = p * cv; u32x2 w; w.x = cvt_pk_bf16(o[0], o[1]); w.y = cvt_pk_bf16(o[2], o[3]);
                *(u32x2*)(M1 + row * 4096 + ch) = w;
                if (rl == 0 || rl == 255) { const int side = rl ? 1 : 0; const size_t eo = ((size_t)u.pm * 2 + side) * 4096 + ch;
                    *(f32x4*)(YE + eo) = y[ai][m];
                    *(f32x4*)(PP + 2 * eo) = p; *(f32x4*)(PP + 2 * eo + 4) = cv; } }
    }
};

struct CtxOrder {
    int c;
    __device__ bool next(int i, pg8::Unit& u) const {
        if (i != 0 || c >= 24) return false;
        u.pm = 64 + c / 12; const int j = c % 12; u.pn = j < 4 ? 8 + j : 16 + j; return true;
    }
};
struct SsmSOrder { int G, c; __device__ bool next(int i, pg8::Unit& u) const { const int L = i * G + c; if (L >= 256) return false; u.pm = L; u.pn = L & 127; return true; } };
struct SsmYOrder { int G, c;
    __device__ bool next(int i, pg8::Unit& u) const {
        if (G == 256) { if (i >= 2) return false; u.pm = c; u.pn = (c & 127) * 2 + i; return true; }
        const int L = i * G + c; if (L >= 512) return false; u.pm = L >> 1; u.pn = ((L >> 1) & 127) * 2 + (L & 1); return true; } };

namespace att {
using bf16 = __hip_bfloat16;
constexpr int D = 128, NW = 8, QBLK = 32, KVBLK = 64, LDQ = 2048, LDK = 512;
constexpr float SCALE = 0.088388347648318440f, THR = 8.f;
using s16x4  = __attribute__((ext_vector_type(4))) short;
using f32x16 = __attribute__((ext_vector_type(16))) float;
constexpr size_t SHM_V = KVBLK * D * 2, SHM_K = KVBLK * D * 2, SHM_ATTN = 2 * SHM_V + 2 * SHM_K + NW * 64 * 4;
#define KSWZ(row, colB) ((row) * 256 + ((colB) ^ (((row) & 7) << 4)))
#define SBAR() __builtin_amdgcn_sched_barrier(0)
__device__ __forceinline__ int crow(int r, int hi) { return (r & 3) + 8 * (r >> 2) + 4 * hi; }
template <bool FIX>
__device__ __forceinline__ void partialSM(f32x16& p0, f32x16& p1, float& m_reg, float& mn, float& alpha, float mfixC) {
  constexpr float C = SCALE * 1.4426950408889634f;
  float mnC;
  if constexpr (FIX) { alpha = 1.f; mn = 0.f; mnC = -mfixC; }
  else {
  float pmax = p0[0]; for (int r = 1; r < 16; ++r) pmax = fmaxf(pmax, p0[r]); for (int r = 0; r < 16; ++r) pmax = fmaxf(pmax, p1[r]);
  { auto rr = __builtin_amdgcn_permlane32_swap(__float_as_uint(pmax), __float_as_uint(pmax), false, false);
    pmax = fmaxf(__uint_as_float(rr[0]), __uint_as_float(rr[1])); }
  if (__builtin_expect(__all(pmax - m_reg <= THR / SCALE), 1)) { mn = m_reg; alpha = 1.f; }
  else { mn = fmaxf(m_reg, pmax); alpha = __builtin_amdgcn_exp2f((m_reg - mn) * C); m_reg = mn; }
  mnC = -mn * C; }
  for (int r = 0; r < 16; ++r) p0[r] = fmaf(p0[r], C, mnC); for (int r = 0; r < 16; ++r) p1[r] = fmaf(p1[r], C, mnC);
  for (int r = 0; r < 16; ++r) p0[r] = __builtin_amdgcn_exp2f(p0[r]);
}
__device__ __forceinline__ void finishSM(f32x16& p0, f32x16& p1, float alpha, float& l_reg, bf16x8& pa0, bf16x8& pa1, bf16x8& pa2, bf16x8& pa3) {
  for (int r = 0; r < 16; ++r) p1[r] = __builtin_amdgcn_exp2f(p1[r]);
  float ps = 0; for (int r = 0; r < 16; ++r) ps += p0[r]; for (int r = 0; r < 16; ++r) ps += p1[r];
  { auto rr = __builtin_amdgcn_permlane32_swap(__float_as_uint(ps), __float_as_uint(ps), false, false);
    ps = __uint_as_float(rr[0]) + __uint_as_float(rr[1]); }
  l_reg = l_reg * alpha + ps;
#define PK4(P, BASE, OUT) do { unsigned a0 = cvt_pk_bf16(P[BASE + 0], P[BASE + 1]), a1 = cvt_pk_bf16(P[BASE + 2], P[BASE + 3]);   \
    unsigned b0 = cvt_pk_bf16(P[BASE + 4], P[BASE + 5]), b1 = cvt_pk_bf16(P[BASE + 6], P[BASE + 7]);                              \
    auto r0 = __builtin_amdgcn_permlane32_swap(a0, b0, false, false); auto r1 = __builtin_amdgcn_permlane32_swap(a1, b1, false, false); \
    u32x4 w = {r0[0], r1[0], r0[1], r1[1]}; OUT = *reinterpret_cast<bf16x8*>(&w); } while (0)
  PK4(p0, 0, pa0); PK4(p0, 8, pa1); PK4(p1, 0, pa2); PK4(p1, 8, pa3);
#undef PK4
}
__device__ __forceinline__ void qkt(f32x16& p0, f32x16& p1, const bf16* Ks, const bf16x8* qr, int r32, int hi) {
  p0 = f32x16{}; p1 = f32x16{};
  for (int d0 = 0; d0 < 8; ++d0) { int cb = (d0 * 16 + hi * 8) * 2;
    bf16x8 b0 = *reinterpret_cast<const bf16x8*>((const char*)Ks + KSWZ(r32, cb));
    bf16x8 b1 = *reinterpret_cast<const bf16x8*>((const char*)Ks + KSWZ(32 + r32, cb));
    p0 = __builtin_amdgcn_mfma_f32_32x32x16_bf16(b0, qr[d0], p0, 0, 0, 0);
    p1 = __builtin_amdgcn_mfma_f32_32x32x16_bf16(b1, qr[d0], p1, 0, 0, 0); }
}
__device__ __forceinline__ int v_st(int k, int c) { const int kk = (k & ~0xC) | ((k & 4) << 1) | ((k & 8) >> 1); return ((kk >> 3) * 4 + (c >> 5)) * 512 + ((kk & 7) * 32 + (c & 31)) * 2; }
__device__ __forceinline__ int v_rd_base(int lane) { return ((lane & 3) << 3) | (((lane >> 2) & 3) << 6) | (((lane >> 4) & 1) << 5) | (((lane >> 5) & 1) << 8); }
constexpr int v_rd_off(int d0, int ks, int half) { return d0 * 512 + ks * 4096 + half * 2048; }
template <int OFF> __device__ __forceinline__ s16x4 tr_read(int vb) {
  s16x4 r; asm volatile("ds_read_b64_tr_b16 %0, %1 offset:%2" : "=&v"(r) : "v"(vb), "i"(OFF) : "memory"); return r;
}
template <int D0> __device__ __forceinline__ void pv_one(f32x16& od, int vb, bf16x8 pa0, bf16x8 pa1, bf16x8 pa2, bf16x8 pa3) {
  const s16x4 l0 = tr_read<v_rd_off(D0, 0, 0)>(vb), h0 = tr_read<v_rd_off(D0, 0, 1)>(vb), l1 = tr_read<v_rd_off(D0, 1, 0)>(vb), h1 = tr_read<v_rd_off(D0, 1, 1)>(vb);
  const s16x4 l2 = tr_read<v_rd_off(D0, 2, 0)>(vb), h2 = tr_read<v_rd_off(D0, 2, 1)>(vb), l3 = tr_read<v_rd_off(D0, 3, 0)>(vb), h3 = tr_read<v_rd_off(D0, 3, 1)>(vb);
  asm volatile("s_waitcnt lgkmcnt(0)" ::: "memory"); SBAR();
#define PK(L, H) (bf16x8){L[0], L[1], L[2], L[3], H[0], H[1], H[2], H[3]}
  od = __builtin_amdgcn_mfma_f32_32x32x16_bf16(pa0, PK(l0, h0), od, 0, 0, 0);
  od = __builtin_amdgcn_mfma_f32_32x32x16_bf16(pa1, PK(l1, h1), od, 0, 0, 0);
  od = __builtin_amdgcn_mfma_f32_32x32x16_bf16(pa2, PK(l2, h2), od, 0, 0, 0);
  od = __builtin_amdgcn_mfma_f32_32x32x16_bf16(pa3, PK(l3, h3), od, 0, 0, 0);
#undef PK
}
__device__ __forceinline__ void pv_d0(f32x16* o, int vb, bf16x8 pa0, bf16x8 pa1, bf16x8 pa2, bf16x8 pa3) {
  pv_one<0>(o[0], vb, pa0, pa1, pa2, pa3); pv_one<1>(o[1], vb, pa0, pa1, pa2, pa3); pv_one<2>(o[2], vb, pa0, pa1, pa2, pa3); pv_one<3>(o[3], vb, pa0, pa1, pa2, pa3);
}
template <bool FIX>
__device__ __forceinline__ void attn_dense_body(const bf16* __restrict__ Qb, const bf16* __restrict__ Kh, const bf16* __restrict__ Vh,
                                                const bf16_t* __restrict__ Gb, bf16_t* __restrict__ Ob, int seq, char* lds, float mfixC) {
  int tid_o = threadIdx.x; asm volatile("" : "+v"(tid_o));
  const int tid = tid_o, wid = tid >> 6, lane = tid & 63, r32 = lane & 31, hi = lane >> 5;
  bf16* V_lds = (bf16*)lds; bf16* K_lds = (bf16*)(lds + 2 * SHM_V);
  float* ws = (float*)(lds + 2 * SHM_V + 2 * SHM_K) + wid * 64; float* li_l = ws;
  float m_reg = -1e30f, l_reg = 0; f32x16 o[4] = {}; bf16x8 qr[8];
  const bf16* Qw = Qb + (long)(wid * QBLK + r32) * LDQ + hi * 8;
#pragma unroll
  for (int d0 = 0; d0 < 8; ++d0) qr[d0] = *reinterpret_cast<const bf16x8*>(Qw + d0 * 16);
  const int sr = tid >> 4, sc = (tid & 15) * 8, vst0 = v_st(sr, sc), vst1 = v_st(32 + sr, sc);
  const int vb0 = (int)(uintptr_t)V_lds + v_rd_base(lane);
  struct { bf16x8 vs0, vs1, ks0, ks1; } sr_[2];
#define SLOAD(i, k0) do { sr_[i].vs0 = *reinterpret_cast<const bf16x8*>(&Vh[(long)((k0) + sr) * LDK + sc]); sr_[i].vs1 = *reinterpret_cast<const bf16x8*>(&Vh[(long)((k0) + 32 + sr) * LDK + sc]); \
    sr_[i].ks0 = *reinterpret_cast<const bf16x8*>(&Kh[(long)((k0) + sr) * LDK + sc]); sr_[i].ks1 = *reinterpret_cast<const bf16x8*>(&Kh[(long)((k0) + 32 + sr) * LDK + sc]); } while (0)
#define SWRITE(b, i) do { *(bf16x8*)((char*)V_lds + (b) * SHM_V + vst0) = sr_[i].vs0;          \
    *(bf16x8*)((char*)V_lds + (b) * SHM_V + vst1) = sr_[i].vs1; int kc = sc * 2;               \
    *(bf16x8*)((char*)K_lds + (b) * SHM_K + KSWZ(sr, kc)) = sr_[i].ks0;                       \
    *(bf16x8*)((char*)K_lds + (b) * SHM_K + KSWZ(32 + sr, kc)) = sr_[i].ks1; } while (0)
#define SWAIT() asm volatile("s_waitcnt vmcnt(4)" ::: "memory")
#define RESC(a) do { if (__any((a) < 1.f)) { int t3 = threadIdx.x; asm volatile("" : "+v"(t3));     \
    float* al_x = (float*)(lds + 2 * SHM_V + 2 * SHM_K) + (t3 >> 6) * 64 + 32; const int hi3 = (t3 >> 5) & 1; \
    if (hi3 == 0) al_x[t3 & 31] = (a); asm volatile("s_waitcnt lgkmcnt(0)" ::: "memory"); \
    for (int d = 0; d < 4; ++d) for (int r = 0; r < 16; ++r) o[d][r] *= al_x[crow(r, hi3)]; } } while (0)
  f32x16 pA0, pA1, pB0, pB1; float mnA, mnB, alA, alB; bf16x8 pa0, pa1, pa2, pa3; const int NT = seq / KVBLK;
  constexpr int SE = 0, SO = 1;
  SLOAD(SE, 0); asm volatile("s_waitcnt vmcnt(0)" ::: "memory"); SWRITE(0, SE); __syncthreads();
  qkt(pA0, pA1, K_lds, qr, r32, hi); partialSM<FIX>(pA0, pA1, m_reg, mnA, alA, mfixC);
  SLOAD(SO, KVBLK); if (2 < NT) SLOAD(SE, 2 * KVBLK);
  SWAIT(); SWRITE(1, SO); __syncthreads();
  for (int j = 1; j + 1 < NT; j += 2) {
    SBAR(); qkt(pB0, pB1, (bf16*)((char*)K_lds + SHM_K), qr, r32, hi);
    finishSM(pA0, pA1, alA, l_reg, pa0, pa1, pa2, pa3); SBAR();
    SLOAD(SO, (j + 2) * KVBLK); SBAR();
    pv_d0(o, vb0, pa0, pa1, pa2, pa3); partialSM<FIX>(pB0, pB1, m_reg, mnB, alB, mfixC);
    __syncthreads(); SWAIT(); SWRITE(0, SE);
    RESC(alB); __syncthreads();
    SBAR(); qkt(pA0, pA1, K_lds, qr, r32, hi);
    finishSM(pB0, pB1, alB, l_reg, pa0, pa1, pa2, pa3); SBAR();
    if (j + 3 < NT) SLOAD(SE, (j + 3) * KVBLK); SBAR();
    pv_d0(o, vb0 + (int)SHM_V, pa0, pa1, pa2, pa3); partialSM<FIX>(pA0, pA1, m_reg, mnA, alA, mfixC);
    __syncthreads(); SWAIT(); SWRITE(1, SO);
    RESC(alA); __syncthreads();
  }
  SBAR(); qkt(pB0, pB1, (bf16*)((char*)K_lds + SHM_K), qr, r32, hi);
  finishSM(pA0, pA1, alA, l_reg, pa0, pa1, pa2, pa3); SBAR();
  pv_d0(o, vb0, pa0, pa1, pa2, pa3); partialSM<FIX>(pB0, pB1, m_reg, mnB, alB, mfixC);
  __syncthreads(); RESC(alB);
  finishSM(pB0, pB1, alB, l_reg, pa0, pa1, pa2, pa3); SBAR();
  pv_d0(o, vb0 + (int)SHM_V, pa0, pa1, pa2, pa3);
  if (hi == 0) li_l[r32] = l_reg; asm volatile("s_waitcnt lgkmcnt(0)" ::: "memory");
  int tid2 = threadIdx.x; asm volatile("" : "+v"(tid2));
  const int lane_o = tid2 & 63, wid2 = tid2 >> 6, odd = lane_o & 1, ce = (lane_o & 30), hio = lane_o >> 5;
  const bf16_t* Gw = Gb + (long)(wid2 * QBLK) * 2048; bf16_t* Ow = Ob + (long)(wid2 * QBLK) * 4096;
#pragma unroll
  for (int r = 0; r < 16; r += 2) { const int rowa = crow(r, hio), rowme = rowa + odd;
    const float ra = __builtin_amdgcn_rcpf(li_l[rowa]), rb = __builtin_amdgcn_rcpf(li_l[rowa + 1]);
#pragma unroll
    for (int d0 = 0; d0 < 4; ++d0) { const float a = o[d0][r] * ra, b = o[d0][r + 1] * rb;
      const float send = odd ? a : b, recv = __shfl_xor(send, 1);
      const float v0 = odd ? recv : a, v1 = odd ? b : recv;
      const unsigned gw = *(const unsigned*)(Gw + (long)rowme * 2048 + d0 * 32 + ce);
      *(unsigned*)(Ow + (long)rowme * 4096 + d0 * 32 + ce) = cvt_pk_bf16(v0 * bf_lo(gw), v1 * bf_hi(gw)); } }
  __syncthreads();
#undef SLOAD
#undef SWRITE
#undef SWAIT
#undef RESC
}

constexpr size_t SHM_K8 = KVBLK * D;
constexpr size_t SHM_ATTN3 = 3 * SHM_V + 3 * SHM_K8 + NW * 64 * 4;
typedef int v8i_a __attribute__((ext_vector_type(8)));
typedef int v4i_a __attribute__((ext_vector_type(4)));
#define KSWZ8(row, colB) ((row) * 128 + ((colB) ^ (((row) & 7) << 4)))
__device__ __forceinline__ void qkt8(f32x16& p0, f32x16& p1, const char* Ks, const v8i_a (&qf)[2], int r32, int hi, const f32x16& cneg) {
  v8i_a kf[2][2];
#pragma unroll
  for (int kh = 0; kh < 2; ++kh)
#pragma unroll
    for (int t = 0; t < 2; ++t) { const int row = 32 * kh + r32, cb = 64 * t + 32 * hi;
      const v4i_a lo = *reinterpret_cast<const v4i_a*>(Ks + KSWZ8(row, cb)), hi4 = *reinterpret_cast<const v4i_a*>(Ks + KSWZ8(row, cb + 16));
      kf[kh][t] = __builtin_shufflevector(lo, hi4, 0, 1, 2, 3, 4, 5, 6, 7); }
  asm volatile("v_mfma_f32_32x32x64_f8f6f4 %0, %1, %2, %3" : "=&v"(p0) : "v"(kf[0][0]), "v"(qf[0]), "v"(cneg));
  asm volatile("v_mfma_f32_32x32x64_f8f6f4 %0, %1, %2, %3" : "=&v"(p1) : "v"(kf[1][0]), "v"(qf[0]), "v"(cneg));
  asm volatile("v_mfma_f32_32x32x64_f8f6f4 %0, %1, %2, %0" : "+v"(p0) : "v"(kf[0][1]), "v"(qf[1]));
  asm volatile("v_mfma_f32_32x32x64_f8f6f4 %0, %1, %2, %0" : "+v"(p1) : "v"(kf[1][1]), "v"(qf[1]));
}
__device__ __forceinline__ float attn_rowmax(const unsigned char* __restrict__ Qb, const unsigned char* __restrict__ Kh, int seq, char* lds) {
  int tid_o = threadIdx.x; asm volatile("" : "+v"(tid_o));
  const int tid = tid_o, wid = tid >> 6, lane = tid & 63, r32 = lane & 31, hi = lane >> 5;
  char* K_lds = lds; v8i_a qf[2];
  { const unsigned char* Qw = Qb + (long)(wid * QBLK + r32) * 2048 + hi * 32;
#pragma unroll
    for (int t = 0; t < 2; ++t) { const v4i_a lo = *reinterpret_cast<const v4i_a*>(Qw + 64 * t), h4 = *reinterpret_cast<const v4i_a*>(Qw + 64 * t + 16); qf[t] = __builtin_shufflevector(lo, h4, 0, 1, 2, 3, 4, 5, 6, 7); } }
  const int kr = tid >> 3, kcb = (tid & 7) * 16, kst = KSWZ8(kr, kcb); float m = -1e30f; const f32x16 czero = {};
  for (int j = 0; j < seq / KVBLK; ++j) {
    const v4i_a k0 = *reinterpret_cast<const v4i_a*>(Kh + (long)(j * KVBLK + kr) * 512 + kcb);
    __syncthreads();
    *(v4i_a*)(K_lds + kst) = k0;
    __syncthreads();
    f32x16 p0, p1; qkt8(p0, p1, K_lds, qf, r32, hi, czero);
    asm volatile("s_nop 15\n\ts_nop 15\n\ts_nop 15\n\ts_nop 15\n\ts_nop 15" ::: "memory");
    for (int r = 0; r < 16; ++r) m = fmaxf(m, fmaxf(p0[r], p1[r]));
  }
  auto rr = __builtin_amdgcn_permlane32_swap(__float_as_uint(m), __float_as_uint(m), false, false);
  m = fmaxf(__uint_as_float(rr[0]), __uint_as_float(rr[1]));
  __syncthreads();
  return m;
}
constexpr int VT_PITCH = 80;
constexpr size_t SHM_VT = 128 * VT_PITCH;
__device__ __forceinline__ void finishSM8(f32x16& p0, f32x16& p1, float& l_reg, v8i_a& pa) {
  for (int r = 0; r < 16; ++r) p1[r] = __builtin_amdgcn_exp2f(p1[r]);
  float ps = 0; for (int r = 0; r < 16; ++r) ps += p0[r]; for (int r = 0; r < 16; ++r) ps += p1[r];
  { auto rr = __builtin_amdgcn_permlane32_swap(__float_as_uint(ps), __float_as_uint(ps), false, false);
    ps = __uint_as_float(rr[0]) + __uint_as_float(rr[1]); }
  l_reg += ps;
#pragma unroll
  for (int q = 0; q < 4; ++q) { int w = __builtin_amdgcn_cvt_pk_bf8_f32(p0[4 * q], p0[4 * q + 1], 0, false); w = __builtin_amdgcn_cvt_pk_bf8_f32(p0[4 * q + 2], p0[4 * q + 3], w, true); pa[q] = w;
    int u = __builtin_amdgcn_cvt_pk_bf8_f32(p1[4 * q], p1[4 * q + 1], 0, false); u = __builtin_amdgcn_cvt_pk_bf8_f32(p1[4 * q + 2], p1[4 * q + 3], u, true); pa[4 + q] = u; }
}
__device__ __forceinline__ void pv8(f32x16* o, const char* Vs, const v8i_a& pa, int r32, int hi) {
  v8i_a vf[4];
#pragma unroll
  for (int d0 = 0; d0 < 4; ++d0) { const char* p = Vs + (32 * d0 + r32) * VT_PITCH + 32 * hi;
    const v4i_a lo = *reinterpret_cast<const v4i_a*>(p), h4 = *reinterpret_cast<const v4i_a*>(p + 16); vf[d0] = __builtin_shufflevector(lo, h4, 0, 1, 2, 3, 4, 5, 6, 7); }
  asm volatile("s_nop 1\n\tv_mfma_f32_32x32x64_f8f6f4 %0, %1, %2, %0 cbsz:1" : "+v"(o[0]) : "v"(pa), "v"(vf[0]));
  asm volatile("v_mfma_f32_32x32x64_f8f6f4 %0, %1, %2, %0 cbsz:1" : "+v"(o[1]) : "v"(pa), "v"(vf[1]));
  asm volatile("v_mfma_f32_32x32x64_f8f6f4 %0, %1, %2, %0 cbsz:1" : "+v"(o[2]) : "v"(pa), "v"(vf[2]));
  asm volatile("v_mfma_f32_32x32x64_f8f6f4 %0, %1, %2, %0 cbsz:1" : "+v"(o[3]) : "v"(pa), "v"(vf[3]));
}
constexpr size_t SHM_ATTN8 = 3 * SHM_VT + 3 * SHM_K8 + NW * 64 * 4;
__device__ __forceinline__ void attn_dense_body3(const unsigned char* __restrict__ Qb, const unsigned char* __restrict__ Kh, const unsigned char* __restrict__ Vt,
                                                 const bf16_t* __restrict__ Gb, bf16_t* __restrict__ Ob, int seq, char* lds, float mfixC) {
  constexpr int VP2 = 144, SLOT_V = 128 * VP2, SLOT_K = 128 * 128;
  int tid_o = threadIdx.x; asm volatile("" : "+v"(tid_o));
  const int tid = tid_o, wid = tid >> 6, lane = tid & 63, r32 = lane & 31, hi = lane >> 5;
  char* V_lds = lds; char* K_lds = lds + 3 * SLOT_V;
  float* li_l = (float*)(lds + 3 * SLOT_V + 3 * SLOT_K) + wid * 64;
  float l_reg = 0; f32x16 o[4] = {}; v8i_a qf[2]; f32x16 cneg;
#pragma unroll
  for (int r = 0; r < 16; ++r) cneg[r] = -mfixC;
  { const unsigned char* Qw = Qb + (long)(wid * QBLK + r32) * 2048 + hi * 32;
#pragma unroll
    for (int t = 0; t < 2; ++t) { const v4i_a lo = *reinterpret_cast<const v4i_a*>(Qw + 64 * t), h4 = *reinterpret_cast<const v4i_a*>(Qw + 64 * t + 16); qf[t] = __builtin_shufflevector(lo, h4, 0, 1, 2, 3, 4, 5, 6, 7); } }
  const int kr = tid >> 3, kcb = (tid & 7) * 16, kst = KSWZ8(kr, kcb);
  const int vd = tid >> 2, vcb = (tid & 3) * 16, vst = vd * VP2 + vcb;
  struct { v4i_a v0, v1, k0, k1; } sg;
  const long SKV_ = seq;
#define SLOAD(p0) do { sg.v0 = *reinterpret_cast<const v4i_a*>(Vt + (long)vd * SKV_ + (p0) + vcb); sg.v1 = *reinterpret_cast<const v4i_a*>(Vt + (long)vd * SKV_ + (p0) + 64 + vcb); \
    sg.k0 = *reinterpret_cast<const v4i_a*>(Kh + (long)((p0) + kr) * 512 + kcb); sg.k1 = *reinterpret_cast<const v4i_a*>(Kh + (long)((p0) + 64 + kr) * 512 + kcb); } while (0)
#define SWRITE(slot) do { *(v4i_a*)(V_lds + (slot) * SLOT_V + vst) = sg.v0; *(v4i_a*)(V_lds + (slot) * SLOT_V + vst + 64) = sg.v1; \
    *(v4i_a*)(K_lds + (slot) * SLOT_K + kst) = sg.k0; *(v4i_a*)(K_lds + (slot) * SLOT_K + 64 * 128 + kst) = sg.k1; } while (0)
#define SWAIT() asm volatile("s_waitcnt vmcnt(0)" ::: "memory")
  f32x16 pA0, pA1, pB0, pB1; v8i_a pa = {}; const int NP = seq / (2 * KVBLK);
#define LD32(p) __builtin_shufflevector(*reinterpret_cast<const v4i_a*>(p), *reinterpret_cast<const v4i_a*>((p) + 16), 0, 1, 2, 3, 4, 5, 6, 7)
#define FSM_CHUNK(P0, P1, c) do { _Pragma("unroll") for (int r_ = 4 * (c); r_ < 4 * (c) + 4; ++r_) P1[r_] = __builtin_amdgcn_exp2f(P1[r_]); \
    ps_ += ((P0[4 * (c)] + P0[4 * (c) + 1]) + (P0[4 * (c) + 2] + P0[4 * (c) + 3])) + ((P1[4 * (c)] + P1[4 * (c) + 1]) + (P1[4 * (c) + 2] + P1[4 * (c) + 3])); \
    { int w_ = __builtin_amdgcn_cvt_pk_bf8_f32(P0[4 * (c)], P0[4 * (c) + 1], pa[c], false); w_ = __builtin_amdgcn_cvt_pk_bf8_f32(P0[4 * (c) + 2], P0[4 * (c) + 3], w_, true); pa[c] = w_; \
      int u_ = __builtin_amdgcn_cvt_pk_bf8_f32(P1[4 * (c)], P1[4 * (c) + 1], pa[4 + (c)], false); u_ = __builtin_amdgcn_cvt_pk_bf8_f32(P1[4 * (c) + 2], P1[4 * (c) + 3], u_, true); pa[4 + (c)] = u_; } } while (0)
#define FSM_END() do { auto rr_ = __builtin_amdgcn_permlane32_swap(__float_as_uint(ps_), __float_as_uint(ps_), false, false); l_reg += __uint_as_float(rr_[0]) + __uint_as_float(rr_[1]); } while (0)
#define EXP_CHUNK(P0, c) do { _Pragma("unroll") for (int r_ = 4 * (c); r_ < 4 * (c) + 4; ++r_) P0[r_] = __builtin_amdgcn_exp2f(P0[r_]); } while (0)
#define MF_QK0(P, KF) asm volatile("v_mfma_f32_32x32x64_f8f6f4 %0, %1, %2, %3" : "=&v"(P) : "v"(KF), "v"(qf[0]), "v"(cneg))
#define MF_QK1(P, KF) asm volatile("v_mfma_f32_32x32x64_f8f6f4 %0, %1, %2, %0" : "+v"(P) : "v"(KF), "v"(qf[1]))
#define MF_PV(O, VF) asm volatile("v_mfma_f32_32x32x64_f8f6f4 %0, %1, %2, %0 cbsz:1" : "+v"(O) : "v"(pa), "v"(VF))
#define LOADK(KS) const char* ks_ = (KS); v8i_a kf_[2][2]; \
    _Pragma("unroll") for (int kh_ = 0; kh_ < 2; ++kh_) _Pragma("unroll") for (int t_ = 0; t_ < 2; ++t_) { const int row_ = 32 * kh_ + r32, cb_ = 64 * t_ + 32 * hi; \
      const v4i_a lo_ = *reinterpret_cast<const v4i_a*>(ks_ + KSWZ8(row_, cb_)), hi_ = *reinterpret_cast<const v4i_a*>(ks_ + KSWZ8(row_, cb_ + 16)); kf_[kh_][t_] = __builtin_shufflevector(lo_, hi_, 0, 1, 2, 3, 4, 5, 6, 7); }
#define STEP_QK(KS, N0, N1, F0, F1) do { LOADK(KS) float ps_ = 0.f; SBAR(); \
    MF_QK0(N0, kf_[0][0]); SBAR(); FSM_CHUNK(F0, F1, 0); SBAR(); \
    MF_QK0(N1, kf_[1][0]); SBAR(); FSM_CHUNK(F0, F1, 1); SBAR(); \
    MF_QK1(N0, kf_[0][1]); SBAR(); FSM_CHUNK(F0, F1, 2); SBAR(); \
    MF_QK1(N1, kf_[1][1]); SBAR(); FSM_CHUNK(F0, F1, 3); FSM_END(); SBAR(); } while (0)
#define STEP_QK_ONLY(KS, N0, N1) do { LOADK(KS) SBAR(); MF_QK0(N0, kf_[0][0]); MF_QK0(N1, kf_[1][0]); MF_QK1(N0, kf_[0][1]); MF_QK1(N1, kf_[1][1]); SBAR(); } while (0)
#define STEP_PV(VS, E0) do { const char* vs_ = (VS) + r32 * VP2 + 32 * hi; v8i_a vf_[4]; \
    _Pragma("unroll") for (int d_ = 0; d_ < 4; ++d_) vf_[d_] = LD32(vs_ + 32 * d_ * VP2); \
    SBAR(); \
    MF_PV(o[0], vf_[0]); SBAR(); EXP_CHUNK(E0, 0); SBAR(); \
    MF_PV(o[1], vf_[1]); SBAR(); EXP_CHUNK(E0, 1); SBAR(); \
    MF_PV(o[2], vf_[2]); SBAR(); EXP_CHUNK(E0, 2); SBAR(); \
    MF_PV(o[3], vf_[3]); SBAR(); EXP_CHUNK(E0, 3); SBAR(); } while (0)
  SLOAD(0); SWAIT(); SWRITE(0); SLOAD(2 * KVBLK); __syncthreads();
  STEP_QK_ONLY(K_lds, pA0, pA1);
  asm volatile("s_nop 15\n\ts_nop 15\n\ts_nop 15\n\ts_nop 15\n\ts_nop 15" ::: "memory");
  EXP_CHUNK(pA0, 0); EXP_CHUNK(pA0, 1); EXP_CHUNK(pA0, 2); EXP_CHUNK(pA0, 3);
  STEP_QK(K_lds + 64 * 128, pB0, pB1, pA0, pA1);
  STEP_PV(V_lds, pB0);
  SWAIT(); SWRITE(1); if (2 < NP) SLOAD(4 * KVBLK); __syncthreads();
  int cur = 1, prv = 0, nxt = 2;
  for (int J = 1; J < NP; ++J) {
    STEP_QK(K_lds + cur * SLOT_K, pA0, pA1, pB0, pB1);
    STEP_PV(V_lds + prv * SLOT_V + 64, pA0);
    STEP_QK(K_lds + cur * SLOT_K + 64 * 128, pB0, pB1, pA0, pA1);
    STEP_PV(V_lds + cur * SLOT_V, pB0);
    if (J + 1 < NP) { SWAIT(); SWRITE(nxt); if (J + 2 < NP) SLOAD((long)(J + 2) * 2 * KVBLK); }
    __syncthreads();
    { const int t = prv; prv = cur; cur = nxt; nxt = t; }
  }
  { float ps_ = 0.f; asm volatile("s_nop 15\n\ts_nop 15\n\ts_nop 15\n\ts_nop 15\n\ts_nop 15" ::: "memory");
    FSM_CHUNK(pB0, pB1, 0); FSM_CHUNK(pB0, pB1, 1); FSM_CHUNK(pB0, pB1, 2); FSM_CHUNK(pB0, pB1, 3); FSM_END(); }
  { const char* vs_ = V_lds + prv * SLOT_V + 64 + r32 * VP2 + 32 * hi; v8i_a vf_[4];
#pragma unroll
    for (int d_ = 0; d_ < 4; ++d_) vf_[d_] = LD32(vs_ + 32 * d_ * VP2);
    MF_PV(o[0], vf_[0]); MF_PV(o[1], vf_[1]); MF_PV(o[2], vf_[2]); MF_PV(o[3], vf_[3]); }
  asm volatile("s_nop 15\n\ts_nop 15\n\ts_nop 15\n\ts_nop 15\n\ts_nop 15" ::: "memory");
  if (hi == 0) li_l[r32] = l_reg; asm volatile("s_waitcnt lgkmcnt(0)" ::: "memory");
  int tid2 = threadIdx.x; asm volatile("" : "+v"(tid2));
  const int lane_o = tid2 & 63, wid2 = tid2 >> 6, odd = lane_o & 1, ce = (lane_o & 30), hio = lane_o >> 5;
  const bf16_t* Gw = Gb + (long)(wid2 * QBLK) * 2048; unsigned char* Ow = (unsigned char*)Ob + (long)(wid2 * QBLK) * 6144;
#pragma unroll
  for (int r = 0; r < 16; r += 2) { const int rowa = crow(r, hio), rowme = rowa + odd;
    const float ra = __builtin_amdgcn_rcpf(li_l[rowa]), rb = __builtin_amdgcn_rcpf(li_l[rowa + 1]);
#pragma unroll
    for (int d0 = 0; d0 < 4; ++d0) { const float a = o[d0][r] * ra, b = o[d0][r + 1] * rb;
      const float send = odd ? a : b, recv = __shfl_xor(send, 1);
      const float v0 = odd ? recv : a, v1 = odd ? b : recv;
      const unsigned gw = *(const unsigned*)(Gw + (long)rowme * 2048 + d0 * 32 + ce);
      *(unsigned short*)(Ow + (long)rowme * 6144 + d0 * 32 + ce) = (unsigned short)__builtin_amdgcn_cvt_pk_fp8_f32(v0 * bf_lo(gw) * 8.f, v1 * bf_hi(gw) * 8.f, 0, false); } }
  __syncthreads();
#undef SLOAD
#undef SWRITE
#undef SWAIT
#undef LD32
#undef FSM_CHUNK
#undef FSM_END
#undef EXP_CHUNK
#undef MF_QK0
#undef MF_QK1
#undef MF_PV
#undef LOADK
#undef STEP_QK
#undef STEP_QK_ONLY
#undef STEP_PV
}
}

__device__ __forceinline__ unsigned f2bf(float f) { unsigned u = __builtin_bit_cast(unsigned, f); return (u + 0x7fffu + ((u >> 16) & 1u)) >> 16; }
__device__ __forceinline__ unsigned pk2(float lo, float hi) { return f2bf(lo) | (f2bf(hi) << 16); }
__device__ __forceinline__ float wave_sum(float v) {
#pragma unroll
    for (int o = 1; o < 64; o <<= 1) v += __shfl_xor(v, o);
    return v;
}
__device__ __forceinline__ int rowmap_in0(int n) {
    if (n >= 2560) return n;
    const int head = n >> 7, d = n & 127, axis = d >> 6, nn = (d >> 5) & 1, f = d & 31;
    return head * 128 + 32 * (2 * axis + (f >> 4)) + 8 * ((f & 15) >> 2) + 4 * nn + (f & 3);
}
__device__ __forceinline__ int rowmap_in1(int n) {
    const int part = n >> 12, ch = n & 4095, pn = ch >> 6, cc = ch & 63;
    return pn * 256 + 128 * (part >> 1) + 32 * (cc >> 4) + 16 * (part & 1) + (cc & 15);
}
__device__ __forceinline__ void transpose_load(const float* W, int N, int item, int lane, f32x4 (&v)[16]) {
    const int nblk = N / 64, kb = item / nblk, nb = item % nblk, k0 = 64 * kb, n0 = 64 * nb;
    const int c4 = lane & 15, r4 = lane >> 4;
    const float* src = W + (size_t)(k0 + r4) * N + n0 + 4 * c4;
#pragma unroll
    for (int i = 0; i < 16; ++i) v[i] = __builtin_nontemporal_load((const f32x4*)(src + (size_t)(4 * i) * N));
}
template <int MAP>
__device__ __forceinline__ void transpose_finish(const f32x4 (&v)[16], int K, int N, bf16_t* WT, LAS float* scr, int item, int lane) {
    const int nblk = N / 64, kb = item / nblk, nb = item % nblk, k0 = 64 * kb, n0 = 64 * nb;
    const int c4 = lane & 15, r4 = lane >> 4;
#pragma unroll
    for (int i = 0; i < 16; ++i) { LAS float* d = scr + (4 * i + r4) * 65 + 4 * c4; d[0] = v[i][0]; d[1] = v[i][1]; d[2] = v[i][2]; d[3] = v[i][3]; }
    LDS_WAIT(); asm volatile("" ::: "memory");
    if (MAP == 1 || MAP == 3 || (MAP == 4 && k0 < 2048)) {
        const int c = lane & 3, nn = lane >> 2; unsigned char* W8 = (unsigned char*)WT;
#pragma unroll
        for (int j = 0; j < 4; ++j) { const int n = nn + 16 * j; const LAS float* s = scr + (16 * c) * 65 + n; u32x4 o;
#pragma unroll
            for (int q = 0; q < 4; ++q) { int w = __builtin_amdgcn_cvt_pk_fp8_f32(s[(4 * q) * 65] * 256.f, s[(4 * q + 1) * 65] * 256.f, 0, false);
                w = __builtin_amdgcn_cvt_pk_fp8_f32(s[(4 * q + 2) * 65] * 256.f, s[(4 * q + 3) * 65] * 256.f, w, true); o[q] = (unsigned)w; }
            *(GAS u32x4*)(W8 + (MAP == 1 ? (size_t)rowmap_in0(n0 + n) * K : (MAP == 3 ? (size_t)(n0 + n) * K : (size_t)(n0 + n) * 6144)) + k0 + 16 * c) = o; }
        LDS_WAIT(); asm volatile("" ::: "memory");
        return;
    }
    const int c = lane & 7, nn = lane >> 3;
#pragma unroll
    for (int j = 0; j < 8; ++j) { const int n = nn + 8 * j; const LAS float* s = scr + (8 * c) * 65 + n;
        u32x4 o; o.x = cvt_pk_bf16(s[0], s[65]); o.y = cvt_pk_bf16(s[130], s[195]); o.z = cvt_pk_bf16(s[260], s[325]); o.w = cvt_pk_bf16(s[390], s[455]);
        const int ns = n0 + n, nd = MAP == 1 ? rowmap_in0(ns) : (MAP == 2 ? rowmap_in1(ns) : ns);
        if (MAP == 4) *(GAS u32x4*)((unsigned char*)WT + (size_t)nd * 6144 + 2048 + (size_t)(k0 - 2048) * 2 + 16 * c) = o;
        else *(GAS u32x4*)(WT + (size_t)nd * K + k0 + 8 * c) = o; }
    LDS_WAIT(); asm volatile("" ::: "memory");
}
template <int MAP>
__device__ __forceinline__ void transpose_item(const float* W, int K, int N, bf16_t* WT, LAS float* scr, int item, int lane) {
    f32x4 v[16]; transpose_load(W, N, item, lane, v); transpose_finish<MAP>(v, K, N, WT, scr, item, lane);
}
template <bool DELTA>
__device__ __forceinline__ void mod_load(const float* xrow, const bf16_t* drow, int lane, f32x4 (&v)[16], u32x2 (&d)[16]) {
#pragma unroll
    for (int j = 0; j < 16; ++j) { v[j] = __builtin_nontemporal_load((const f32x4*)(xrow + 256 * j + 4 * lane)); if (DELTA) d[j] = __builtin_nontemporal_load((const u32x2*)(drow + 256 * j + 4 * lane)); }
}
template <bool DELTA, bool OUT8 = false>
__device__ __forceinline__ void mod_finish(f32x4 (&v)[16], const u32x2 (&d)[16], const float* nw, const float* shift, const float* scale, bf16_t* orow, int lane) {
    float s = 0.f;
#pragma unroll
    for (int j = 0; j < 16; ++j) { if (DELTA) { v[j][0] += bf_lo(d[j].x); v[j][1] += bf_hi(d[j].x); v[j][2] += bf_lo(d[j].y); v[j][3] += bf_hi(d[j].y); }
        s += (v[j][0] * v[j][0] + v[j][1] * v[j][1]) + (v[j][2] * v[j][2] + v[j][3] * v[j][3]); }
    const float rstd = __builtin_amdgcn_rsqf(wave_sum(s) * (1.0f / DM) + EPS);
#pragma unroll
    for (int j = 0; j < 16; ++j) { const int c = 256 * j + 4 * lane; const f32x4 w = *(const f32x4*)(nw + c), sh = *(const f32x4*)(shift + c), sc = *(const f32x4*)(scale + c);
        const f32x4 o = v[j] * rstd * w * (sc + 1.0f) + sh;
        if (OUT8) { int w8 = __builtin_amdgcn_cvt_pk_fp8_f32(o[0], o[1], 0, false); w8 = __builtin_amdgcn_cvt_pk_fp8_f32(o[2], o[3], w8, true); __builtin_nontemporal_store(w8, (int*)((unsigned char*)orow + c)); }
        else { u32x2 p; p.x = cvt_pk_bf16(o[0], o[1]); p.y = cvt_pk_bf16(o[2], o[3]); __builtin_nontemporal_store(p, (u32x2*)(orow + c)); }
        if ((j & 3) == 3) asm volatile("" ::: "memory"); }
}
template <bool OUT8>
__device__ __forceinline__ void modulate_row(const float* xrow, const float* nw, const float* shift, const float* scale, bf16_t* orow, int lane) {
    f32x4 v[16]; u32x2 d[16]; mod_load<false>(xrow, nullptr, lane, v, d); mod_finish<false, OUT8>(v, d, nw, shift, scale, orow, lane);
}
template <bool DELTA>
__device__ __forceinline__ void modulate_rows(const float* X, const bf16_t* Dl, const float* nw, const float* mod, bf16_t* O, int m0, int step, int mend, int lane) {
    if (m0 >= mend) return;
    if (DELTA) {
        for (int m = m0; m < mend; m += step) { f32x4 v[16]; u32x2 d[16]; mod_load<DELTA>(X + (size_t)m * DM, Dl + (size_t)m * DM, lane, v, d);
            const float* md = mod + (m >> 13) * 12288; mod_finish<DELTA>(v, d, nw, md, md + 4096, O + (size_t)m * DM, lane); }
        return;
    }
    f32x4 va[16], vb[16]; u32x2 da[16], db[16];
    mod_load<DELTA>(X + (size_t)m0 * DM, Dl + (size_t)m0 * DM, lane, va, da);
    for (int m = m0; m < mend; m += 2 * step) {
        const int m1 = m + step, m2 = m + 2 * step;
        if (m1 < mend) mod_load<DELTA>(X + (size_t)m1 * DM, Dl + (size_t)m1 * DM, lane, vb, db);
        { const float* md = mod + (m >> 13) * 12288; mod_finish<DELTA>(va, da, nw, md, md + 4096, O + (size_t)m * DM, lane); }
        if (m1 >= mend) break;
        if (m2 < mend) mod_load<DELTA>(X + (size_t)m2 * DM, Dl + (size_t)m2 * DM, lane, va, da);
        { const float* md = mod + (m1 >> 13) * 12288; mod_finish<DELTA>(vb, db, nw, md, md + 4096, O + (size_t)m1 * DM, lane); }
    }
}

__global__ void __launch_bounds__(NTHREADS, 2) fwd_kernel(Args args) {
    extern __shared__ __attribute__((aligned(16))) unsigned char lds_raw[];
    LAS unsigned char* lds = (LAS unsigned char*)lds_raw;
    const int tid = threadIdx.x, lane = tid & 63, wave = __builtin_amdgcn_readfirstlane(tid >> 6);
    const int G = gridDim.x, bx = blockIdx.x;
    unsigned char* ws = args.ws;
    unsigned* ctl = (unsigned*)(ws + WS_CTL);
    volatile LAS unsigned* MISC = (volatile LAS unsigned*)(lds + LDSCTL_OFF);
    for (int u = tid; u < 128; u += NTHREADS) MISC[u] = 0u;
    __syncthreads();
    XcdBarrier bar; bar.bar = ctl + CW_BAR; bar.x = 0; bar.st = nullptr;
    if (MK_ONE_LAUNCH) bar = xcd_barrier_post(ctl + CW_BAR, MISC + 8);
    const int lo = args.ph_lo, hi = args.ph_hi;
#ifndef PH_MASK
#define PH_MASK 0x3fff
#endif
#define IN(k) (((PH_MASK >> (k)) & 1) && lo <= (k) && (k) < hi)
#define SEAM(k) do { if (IN(k) && IN((k) + 1)) xcd_barrier(bar); } while (0)
#ifndef DBL_MASK
#define DBL_MASK 0
#endif
#define PH_BEGIN(k) if (IN(k)) for (int rep_ = 0; rep_ <= ((DBL_MASK >> (k)) & 1); ++rep_) {
#define PH_END(k) if (rep_ < ((DBL_MASK >> (k)) & 1)) xcd_barrier(bar); }

    const float* x = args.in[0]; const float* cvec = args.in[1]; const float* ctxin = args.in[2]; const float* cctx = args.in[3];
    const float* l0_norm_w = args.in[4]; const float* l0_w_mod = args.in[5]; const float* l0_b_mod = args.in[6]; const float* l0_w_in = args.in[7];
    const float* l0_q_norm_w = args.in[8]; const float* l0_k_norm_w = args.in[9];
    const float* l0_ssm_d = args.in[24]; const float* l0_w_glu = args.in[25]; const float* l0_b_glu = args.in[26]; const float* l0_w_out = args.in[27];
    const float* l1_norm_w = args.in[28]; const float* l1_w_mod = args.in[29]; const float* l1_b_mod = args.in[30]; const float* l1_w_in = args.in[31];
    const float* l1_conv_w = args.in[32]; const float* l1_conv_b = args.in[33]; const float* l1_w_out = args.in[34];
    float* out = args.out;
    float* MOD = (float*)(ws + WS_MOD);
    float* SA1 = (float*)(ws + WS_SSMP + SSMP_A1); float* SA32 = (float*)(ws + WS_SSMP + SSMP_A32); float* SBB = (float*)(ws + WS_SSMP + SSMP_BB);
    float* ROPEC = (float*)(ws + WS_ROPE); float* ROPES = ROPEC + 128 * 32;
    float* YE = (float*)(ws + WS_YE); float* PP = (float*)(ws + WS_PP);
    bf16_t* UCTX = (bf16_t*)(ws + WS_UCTX);
    bf16_t* BT0 = (bf16_t*)(ws + WS_BT0); bf16_t* WGT = (bf16_t*)(ws + WS_WGT); bf16_t* WO0 = (bf16_t*)(ws + WS_WO0); bf16_t* BT1 = (bf16_t*)(ws + WS_BT1); bf16_t* WO1 = (bf16_t*)(ws + WS_WO1);
    bf16_t* PT = (bf16_t*)(ws + WS_PT); bf16_t* KMT = (bf16_t*)(ws + WS_KMT);
    bf16_t* XN = (bf16_t*)(ws + WS_XN); unsigned char* Q8B = ws + WS_XN + 68 * MiB; unsigned char* K8B = ws + WS_XN + 100 * MiB; unsigned char* V8TB = ws + WS_XN + 110 * MiB;     bf16_t* QB = (bf16_t*)(ws + WS_Q); bf16_t* KB = (bf16_t*)(ws + WS_K); bf16_t* VB = (bf16_t*)(ws + WS_V);
    bf16_t* GA = (bf16_t*)(ws + WS_GA); bf16_t* GS = (bf16_t*)(ws + WS_GS); bf16_t* M1 = (bf16_t*)(ws + WS_M1);
    bf16_t* D0 = (bf16_t*)(ws + WS_D0); unsigned char* YG8 = ws + WS_MIX + 96 * MiB;     bf16_t* AS = (bf16_t*)(ws + WS_AS); bf16_t* YG = (bf16_t*)(ws + WS_YG); bf16_t* MIX = (bf16_t*)(ws + WS_MIX); float* SB = (float*)(ws + WS_S);

    PH_BEGIN(0)
        for (int i = bx * NTHREADS + tid; i < 128 * 32; i += G * NTHREADS) { const int pos = i >> 5, f = i & 31;
            const float inv = exp2f(-(float)(2 * f) * (13.287712379549449f / 64.0f)); float sn, cs; sincosf((float)pos * inv, &sn, &cs); ROPEC[i] = cs; ROPES[i] = sn; }
        constexpr int I0 = 64 * (NIN0 / 64), IG = 32 * 32, IO = 64 * 64, I1 = 64 * (NIN1 / 64);
        constexpr int NTR = I0 + IG, NQ = 192 + 256 + NTR / 8;
        static_assert(NTR % 8 == 0, "weight-copy items come in batches of 8");
        volatile LAS int* qslot = (volatile LAS int*)(lds + LDSCTL_OFF + 256);
        for (;;) {
            if (tid == 0) *qslot = (int)atomicAdd(ctl + CW_QCTR + 64 * rep_, 1u);
            __syncthreads();
            const int qit = __builtin_amdgcn_readfirstlane(*qslot);
            __syncthreads();
            if (qit >= NQ) break;
            if (qit < 192)
            { const int it = qit;
            const int layer = it / 96, chunk = it % 96; const float* W = layer ? l1_w_mod : l0_w_mod; const float* bm = layer ? l1_b_mod : l0_b_mod;
            LAS float* sc = (LAS float*)lds;
            LAS float* red = (LAS float*)(lds + 49152);
            for (int i = tid; i < 3 * 4096; i += NTHREADS) { const int v = i >> 12, k = i & 4095; const float cv = v < 2 ? cvec[v * 4096 + k] : cctx[k]; sc[i] = siluf_(cv); }
            __syncthreads();
            f32x4 a0 = (f32x4){0.f, 0.f, 0.f, 0.f}, a1 = a0, a2 = a0;
            const int kr = lane >> 5, c4 = (lane & 31) * 4; const float* wp = W + (size_t)(wave * 512 + kr) * 12288 + chunk * 128 + c4;
            f32x4 wa[8], wb[8];
#define GV_LOAD(dst, i0) do { _Pragma("unroll") for (int q_ = 0; q_ < 8; ++q_) dst[q_] = __builtin_nontemporal_load((const f32x4*)(wp + (size_t)(2 * ((i0) + q_)) * 12288)); asm volatile("" ::: "memory"); } while (0)
#define GV_USE(src, i0) do { _Pragma("unroll") for (int q_ = 0; q_ < 8; ++q_) { const int k = wave * 512 + 2 * ((i0) + q_) + kr; a0 += src[q_] * sc[k]; a1 += src[q_] * sc[4096 + k]; a2 += src[q_] * sc[8192 + k]; } } while (0)
            GV_LOAD(wa, 0);
            for (int i0 = 0; i0 < 256; i0 += 16) {
                GV_LOAD(wb, i0 + 8);
                GV_USE(wa, i0);
                if (i0 + 16 < 256) GV_LOAD(wa, i0 + 16);
                GV_USE(wb, i0 + 8);
            }
#undef GV_LOAD
#undef GV_USE
#pragma unroll
            for (int e = 0; e < 4; ++e) { a0[e] += __shfl_xor(a0[e], 32); a1[e] += __shfl_xor(a1[e], 32); a2[e] += __shfl_xor(a2[e], 32); }
            if (lane < 32) { *(LAS f32x4*)(red + (wave * 3 + 0) * 128 + c4) = a0; *(LAS f32x4*)(red + (wave * 3 + 1) * 128 + c4) = a1; *(LAS f32x4*)(red + (wave * 3 + 2) * 128 + c4) = a2; }
            __syncthreads();
            if (tid < 384) { const int v = tid >> 7, col = tid & 127; float s = 0.f;
#pragma unroll
                for (int w = 0; w < 8; ++w) s += red[(w * 3 + v) * 128 + col];
                MOD[(layer * 3 + v) * 12288 + chunk * 128 + col] = s + bm[chunk * 128 + col]; }
            __syncthreads();
        }
            else if (qit < 448)
            { const int it = qit - 192;
            const int g = it >> 1, hf = it & 1;
            LAS float* AP = (LAS float*)lds;
            LAS float* BB = (LAS float*)(lds + 33792);
            LAS float* CC = (LAS float*)(lds + 33792 + 16384);
            LAS float* KT = (LAS float*)(lds + 33792 + 32768);
            if (tid < 128) { const int dir = tid >> 6, p = tid & 63; const int ib = 10 + 7 * dir;
                const float lr = args.in[ib][g * 64 + p], li = args.in[ib + 1][g * 64 + p], dt = expf(args.in[ib + 2][g]);
                const float mag = expf(lr * dt); float sn, cs; sincosf(li * dt, &sn, &cs); const float ar = mag * cs, aim = mag * sn;
                float pr = 1.f, pi = 0.f;
                for (int k = 0; k <= 32; ++k) { AP[((dir * 33 + k) * 64 + p) * 2] = pr; AP[((dir * 33 + k) * 64 + p) * 2 + 1] = pi;
                    if (k == 1 && hf == 0) { SA1[((dir * 128 + g) * 64 + p) * 2] = pr; SA1[((dir * 128 + g) * 64 + p) * 2 + 1] = pi; }
                    if (k == 32 && hf == 0) { SA32[((dir * 128 + g) * 64 + p) * 2] = pr; SA32[((dir * 128 + g) * 64 + p) * 2 + 1] = pi; }
                    const float nr = pr * ar - pi * aim, ni = pr * aim + pi * ar; pr = nr; pi = ni; }
                const float den = lr * lr + li * li, nre = ar - 1.0f, cr = (nre * lr + aim * li) / den, ci = (aim * lr - nre * li) / den;
                for (int j = 0; j < 16; ++j) { const float br = args.in[ib + 3][(g * 64 + p) * 16 + j], bi = args.in[ib + 4][(g * 64 + p) * 16 + j];
                    const float vr = cr * br - ci * bi, vi = cr * bi + ci * br; BB[((dir * 64 + p) * 16 + j) * 2] = vr; BB[((dir * 64 + p) * 16 + j) * 2 + 1] = vi;
                    if (hf == 0) { SBB[(((size_t)(dir * 128 + g) * 64 + p) * 16 + j) * 2] = vr; SBB[(((size_t)(dir * 128 + g) * 64 + p) * 16 + j) * 2 + 1] = vi; } }
                for (int i = 0; i < 16; ++i) { CC[((dir * 16 + i) * 64 + p) * 2] = args.in[ib + 5][(g * 16 + i) * 64 + p]; CC[((dir * 16 + i) * 64 + p) * 2 + 1] = args.in[ib + 6][(g * 16 + i) * 64 + p]; }
            }
            __syncthreads();
            for (int pr_ = tid; pr_ < 63 * 16; pr_ += NTHREADS) { const int dd = pr_ >> 4, i = pr_ & 15, d = dd - 31;
                float accj[16];
#pragma unroll
                for (int j = 0; j < 16; ++j) accj[j] = 0.f;
#pragma unroll
                for (int dir = 0; dir < 2; ++dir) { const bool use = dir == 0 ? d >= 0 : d <= 0; const int k = d >= 0 ? d : -d;
                    if (use) for (int p = 0; p < 64; ++p) { const f32x2 c = *(const LAS f32x2*)(CC + ((dir * 16 + i) * 64 + p) * 2), a = *(const LAS f32x2*)(AP + ((dir * 33 + k) * 64 + p) * 2);
                        const float car = c.x * a.x - c.y * a.y, cai = c.x * a.y + c.y * a.x;
#pragma unroll
                        for (int j4 = 0; j4 < 8; ++j4) { const f32x4 b = *(const LAS f32x4*)(BB + ((dir * 64 + p) * 16 + 2 * j4) * 2);
                            accj[2 * j4] += car * b[0] - cai * b[1]; accj[2 * j4 + 1] += car * b[2] - cai * b[3]; } } }
                if (d == 0) { const float dv = l0_ssm_d[g * 16 + i];
#pragma unroll
                    for (int j = 0; j < 16; ++j) accj[j] += (j == i) ? dv : 0.f; }
#pragma unroll
                for (int j = 0; j < 16; ++j) KT[(dd * 16 + i) * 16 + j] = accj[j]; }
            __syncthreads();
            bf16_t* kmt = KMT + (size_t)g * 512 * 768;
            for (int cidx = tid; cidx < 256 * 64; cidx += NTHREADS) { const int nl = cidx >> 6, kc = cidx & 63, n = hf * 256 + nl, tau = n >> 4, i = n & 15, s = kc >> 1, j0 = (kc & 1) * 8;
                const LAS float* kp = KT + ((tau - s + 31) * 16 + i) * 16 + j0; const f32x4 a = *(const LAS f32x4*)kp, b = *(const LAS f32x4*)(kp + 4);
                u32x4 o; o.x = cvt_pk_bf16(a[0], a[1]); o.y = cvt_pk_bf16(a[2], a[3]); o.z = cvt_pk_bf16(b[0], b[1]); o.w = cvt_pk_bf16(b[2], b[3]);
                *(u32x4*)(kmt + (size_t)n * 768 + kc * 8) = o; }
            for (int cidx = tid; cidx < 256 * 32; cidx += NTHREADS) { const int nl = cidx >> 5, kc = cidx & 31, n = hf * 256 + nl, tau = n >> 4, i = n & 15, q = kc >> 3, p0 = (kc & 7) * 8, dir = q >> 1;
                const int k = dir == 0 ? tau + 1 : 32 - tau; float v[8];
#pragma unroll
                for (int e = 0; e < 8; ++e) { const int p = p0 + e; const f32x2 c = *(const LAS f32x2*)(CC + ((dir * 16 + i) * 64 + p) * 2), a = *(const LAS f32x2*)(AP + ((dir * 33 + k) * 64 + p) * 2);
                    v[e] = (q & 1) ? -(c.x * a.y + c.y * a.x) : (c.x * a.x - c.y * a.y); }
                u32x4 o; o.x = cvt_pk_bf16(v[0], v[1]); o.y = cvt_pk_bf16(v[2], v[3]); o.z = cvt_pk_bf16(v[4], v[5]); o.w = cvt_pk_bf16(v[6], v[7]);
                *(u32x4*)(kmt + (size_t)n * 768 + 512 + kc * 8) = o; }
            bf16_t* pt = PT + (size_t)g * 256 * 512;
            for (int cidx = tid; cidx < 128 * 64; cidx += NTHREADS) { const int nl = cidx >> 6, kc = cidx & 63, np = hf * 128 + nl, q = np >> 6, p = np & 63, dir = hf, tau = kc >> 1, j0 = (kc & 1) * 8;
                const int k = dir == 0 ? 31 - tau : tau; const f32x2 a = *(const LAS f32x2*)(AP + ((dir * 33 + k) * 64 + p) * 2); float v[8];
#pragma unroll
                for (int e = 0; e < 8; ++e) { const f32x2 b = *(const LAS f32x2*)(BB + ((dir * 64 + p) * 16 + j0 + e) * 2); v[e] = (q & 1) ? (a.x * b.y + a.y * b.x) : (a.x * b.x - a.y * b.y); }
                u32x4 o; o.x = cvt_pk_bf16(v[0], v[1]); o.y = cvt_pk_bf16(v[2], v[3]); o.z = cvt_pk_bf16(v[4], v[5]); o.w = cvt_pk_bf16(v[6], v[7]);
                *(u32x4*)(pt + (size_t)np * 512 + kc * 8) = o; }
            __syncthreads();
        }
            else { LAS float* scr = (LAS float*)(lds + wave * 16640); int r = (qit - 448) * 8 + wave;
                if (r < I0) transpose_item<1>(l0_w_in, DM, NIN0, BT0, scr, r, lane);
                else { r -= I0; transpose_item<3>(l0_w_glu, 2048, 2048, WGT, scr, r, lane); } }
        }
    PH_END(0)
    SEAM(0);

    PH_BEGIN(1)
    PH_END(1)

    PH_BEGIN(2)
        if (bx < 24 && G > 24) {
            for (int m = bx * NWAVES + wave; m < MCTX; m += 24 * NWAVES)
                modulate_row<true>(ctxin + (size_t)m * DM, l0_norm_w, MOD + 2 * 12288, MOD + 2 * 12288 + 4096, (bf16_t*)((unsigned char*)XN + (size_t)(MLAT + m) * DM), lane);
            asm volatile("s_waitcnt vmcnt(0)" ::: "memory");
            __syncthreads();
            if (tid == 0) { unsigned* gctr = ctl + 2048;
                __builtin_amdgcn_fence(__ATOMIC_RELEASE, "agent"); asm volatile("s_waitcnt vmcnt(0)" ::: "memory");
                (void)xb_add(gctr, 1u);
                XB_SPIN(xb_ld(gctr) < 24u * (unsigned)(rep_ + 1), ctl + CW_BAR);
                __builtin_amdgcn_fence(__ATOMIC_ACQUIRE, "agent"); asm volatile("s_waitcnt vmcnt(0)" ::: "memory"); }
            __syncthreads();
            pg8::Gemm g{XN, BT0, DM / 2, DM / 2, DM, 0}; CtxOrder S{bx};
            EpiIn0 E{QB, KB, VB, GA, GS, AS, UCTX, l0_q_norm_w, l0_k_norm_w, ROPEC, ROPES, (LAS float*)(lds + EPI_OFF), Q8B, K8B, V8TB};
            pg8::gemm_phase<EpiIn0, CtxOrder, true>(lds, g, S, E);
        } else {
            const int gw = (bx - 24) * NWAVES + wave, NGW = (G - 24) * NWAVES;
            for (int m = gw; m < MLAT; m += NGW) { const int v = m >> 13;
                modulate_row<true>(x + (size_t)m * DM, l0_norm_w, MOD + v * 12288, MOD + v * 12288 + 4096, (bf16_t*)((unsigned char*)XN + (size_t)m * DM), lane); }
        }
    PH_END(2)
    SEAM(2);

    PH_BEGIN(3)
        pg8::Gemm g{XN, BT0, DM / 2, DM / 2, DM, 0}; pg8::StaticOrder S; S.init(MLAT, NIN0, G, bx);
        EpiIn0 E{QB, KB, VB, GA, GS, AS, UCTX, l0_q_norm_w, l0_k_norm_w, ROPEC, ROPES, (LAS float*)(lds + EPI_OFF), Q8B, K8B, V8TB};
        pg8::gemm_phase<EpiIn0, pg8::StaticOrder, true>(lds, g, S, E);
    PH_END(3)
    SEAM(3);

    PH_BEGIN(4)
        pg8::Gemm g{AS, PT, 768, 512, 512, 0}; SsmSOrder S{G, bx}; EpiS E{SB};
        pg8::gemm_phase<EpiS, SsmSOrder>(lds, g, S, E);
    PH_END(4)
    if (G == 256) { if (IN(4) && IN(5)) { asm volatile("s_waitcnt vmcnt(0)" ::: "memory"); __builtin_amdgcn_fence(__ATOMIC_RELEASE, "workgroup"); __syncthreads(); __builtin_amdgcn_fence(__ATOMIC_ACQUIRE, "workgroup"); } }
    else SEAM(4);

    PH_BEGIN(5)
        for (int it = bx; it < 256; it += G) {
            const int b = it >> 7, g = it & 127;
            LAS float* SL = (LAS float*)lds;
            const int dir = (tid >> 6) & 1, p = tid & 63;
            float hr = 0.f, hi_ = 0.f, a32r = 0.f, a32i = 0.f;
            { LAS float* BU = (LAS float*)lds; LAS unsigned char* UL = lds + 131072;
              const bf16_t* uc = UCTX + (size_t)(b * NGRP + g) * CTXL * 16;
              *(LAS u32x4*)(UL + tid * 16) = *(const u32x4*)(uc + tid * 8);
              float br[16], bi[16];
#pragma unroll
              for (int j = 0; j < 16; j += 2) { const f32x4 v = *(const f32x4*)(SBB + (((size_t)(dir * 128 + g) * 64 + p) * 16 + j) * 2); br[j] = v[0]; bi[j] = v[1]; br[j + 1] = v[2]; bi[j + 1] = v[3]; }
              float a1r = 0.f, a1i = 0.f;
              if (tid < 128) { a1r = SA1[((dir * 128 + g) * 64 + p) * 2]; a1i = SA1[((dir * 128 + g) * 64 + p) * 2 + 1];
                  a32r = SA32[((dir * 128 + g) * 64 + p) * 2]; a32i = SA32[((dir * 128 + g) * 64 + p) * 2 + 1]; }
              const int sgrp = tid >> 7;
              for (int half = 0; half < 2; ++half) {
                  __syncthreads();
#pragma unroll 2
                  for (int sl = sgrp * 32; sl < sgrp * 32 + 32; ++sl) { const int so = half * 128 + sl, ss = dir == 0 ? so : CTXL - 1 - so;
                      const u32x4 w0 = *(const LAS u32x4*)(UL + ss * 32), w1 = *(const LAS u32x4*)(UL + ss * 32 + 16);
                      const float uu[16] = {bf_lo(w0.x), bf_hi(w0.x), bf_lo(w0.y), bf_hi(w0.y), bf_lo(w0.z), bf_hi(w0.z), bf_lo(w0.w), bf_hi(w0.w),
                                            bf_lo(w1.x), bf_hi(w1.x), bf_lo(w1.y), bf_hi(w1.y), bf_lo(w1.z), bf_hi(w1.z), bf_lo(w1.w), bf_hi(w1.w)};
                      float xr = 0.f, xi = 0.f;
#pragma unroll
                      for (int j = 0; j < 16; ++j) { xr += br[j] * uu[j]; xi += bi[j] * uu[j]; }
                      f32x2 o; o.x = xr; o.y = xi; *(LAS f32x2*)(BU + ((dir * 128 + sl) * 64 + p) * 2) = o; }
                  __syncthreads();
                  if (tid < 128) {
#pragma unroll 8
                      for (int sl = 0; sl < 128; ++sl) { const f32x2 x = *(const LAS f32x2*)(BU + ((dir * 128 + sl) * 64 + p) * 2);
                          const float nr = a1r * hr - a1i * hi_ + x.x, ni = a1r * hi_ + a1i * hr + x.y; hr = nr; hi_ = ni; } }
              }
              __syncthreads(); }
            for (int i = tid; i < 256 * 32; i += NTHREADS) { const int c = i >> 5, q4 = (i & 31) * 4; *(LAS f32x4*)(SL + c * 128 + q4) = *(const f32x4*)(SB + ((size_t)it * 256 + c) * 256 + q4); }
            __syncthreads();
            bf16_t* asrow = AS + (size_t)it * 256 * 768 + 512;
            if (tid < 64) {
#pragma unroll 8
                for (int c = 0; c < 256; ++c) { const float sr = SL[c * 128 + p], si = SL[c * 128 + 64 + p]; SL[c * 128 + p] = hr; SL[c * 128 + 64 + p] = hi_;
                    const float nr = a32r * hr - a32i * hi_ + sr, ni = a32r * hi_ + a32i * hr + si; hr = nr; hi_ = ni; }
            }
            __syncthreads();
            for (int i = tid; i < 256 * 64; i += NTHREADS) { const int c = i >> 6, q2 = (i & 63) * 2; const f32x2 h2 = *(const LAS f32x2*)(SL + c * 128 + q2);
                *(unsigned*)(asrow + (size_t)c * 768 + q2) = cvt_pk_bf16(h2.x, h2.y); }
            __syncthreads();
            for (int i = tid; i < 256 * 32; i += NTHREADS) { const int c = i >> 5, q4 = (i & 31) * 4; *(LAS f32x4*)(SL + c * 128 + q4) = *(const f32x4*)(SB + ((size_t)it * 256 + c) * 256 + 128 + q4); }
            __syncthreads();
            if (tid >= 64 && tid < 128) {
#pragma unroll 8
                for (int c = 255; c >= 0; --c) { const float sr = SL[c * 128 + p], si = SL[c * 128 + 64 + p]; SL[c * 128 + p] = hr; SL[c * 128 + 64 + p] = hi_;
                    const float nr = a32r * hr - a32i * hi_ + sr, ni = a32r * hi_ + a32i * hr + si; hr = nr; hi_ = ni; }
            }
            __syncthreads();
            for (int i = tid; i < 256 * 64; i += NTHREADS) { const int c = i >> 6, q2 = (i & 63) * 2; const f32x2 h2 = *(const LAS f32x2*)(SL + c * 128 + q2);
                *(unsigned*)(asrow + (size_t)c * 768 + 128 + q2) = cvt_pk_bf16(h2.x, h2.y); }
            __syncthreads();
        }
    PH_END(5)
    if (G == 256) { if (IN(5) && IN(6)) { asm volatile("s_waitcnt vmcnt(0)" ::: "memory"); __builtin_amdgcn_fence(__ATOMIC_RELEASE, "workgroup"); __syncthreads(); __builtin_amdgcn_fence(__ATOMIC_ACQUIRE, "workgroup"); } }
    else SEAM(5);

    PH_BEGIN(6)
        pg8::Gemm g{AS, KMT, 768, 768, 768, 0}; SsmYOrder S{G, bx}; EpiY E{YG, YG8};
        pg8::gemm_phase<EpiY, SsmYOrder>(lds, g, S, E);
    PH_END(6)
    SEAM(6);

    PH_BEGIN(7)
        pg8::Gemm g{(const bf16_t*)YG8, WGT, 1024, 1024, 1024, 16}; pg8::StaticOrder S; S.init(MLAT, 2048, G, bx); EpiGlu E{YG, GS, l0_b_glu, MIX};
        pg8::gemm_phase<EpiGlu, pg8::StaticOrder, 2>(lds, g, S, E);
    PH_END(7)

    PH_BEGIN(8)
        float mq = fmaxf(fabsf(l0_q_norm_w[lane]), fabsf(l0_q_norm_w[lane + 64])), mk = fmaxf(fabsf(l0_k_norm_w[lane]), fabsf(l0_k_norm_w[lane + 64]));
#pragma unroll
        for (int o = 1; o < 64; o <<= 1) { mq = fmaxf(mq, __shfl_xor(mq, o)); mk = fmaxf(mk, __shfl_xor(mk, o)); }
        const float mfixC = 128.0f * mq * mk * 1.13f * QK_LOG2_SCALE;
        const bool fixmax = mfixC < 24.0f;
#ifndef ATT_FORCE_PREPASS
#define ATT_FORCE_PREPASS 0
#endif
        constexpr int L1_I1 = 64 * (NIN1 / 64), L1_I2 = L1_I1 + 64 * 64, L1_ITEMS = L1_I2 + 64 * 64;
        const int l1_per = (L1_ITEMS + G * NWAVES - 1) / (G * NWAVES), l1_slot = (bx & 7) % 5;
        auto l1_copies = [&]() {
            __syncthreads();
            int tid_c = threadIdx.x; asm volatile("" : "+v"(tid_c));
            const int lane_c = tid_c & 63, wave_c = __builtin_amdgcn_readfirstlane(tid_c >> 6);
            LAS float* scr = (LAS float*)(lds + wave_c * 16640);
            auto ld = [&](int r, f32x4 (&v)[16]) { if (r < L1_I1) transpose_load(l1_w_in, NIN1, r, lane_c, v); else if (r < L1_I2) transpose_load(l1_w_out, DM, r - L1_I1, lane_c, v); else if (r < L1_ITEMS) transpose_load(l0_w_out, DM, r - L1_I2, lane_c, v); };
            auto fin = [&](int r, const f32x4 (&v)[16]) { if (r < L1_I1) transpose_finish<2>(v, DM, NIN1, BT1, scr, r, lane_c); else if (r < L1_I2) transpose_finish<0>(v, DM, DM, WO1, scr, r - L1_I1, lane_c); else if (r < L1_ITEMS) transpose_finish<4>(v, DM, DM, WO0, scr, r - L1_I2, lane_c); };
            f32x4 va[16], vb[16]; const int rb = bx * l1_per * NWAVES + wave_c;
            ld(rb, va);
            for (int j = 0; j < l1_per; j += 2) {
                if (j + 1 < l1_per) ld(rb + (j + 1) * NWAVES, vb);
                asm volatile("" ::: "memory");
                fin(rb + j * NWAVES, va);
                if (j + 1 >= l1_per) break;
                if (j + 2 < l1_per) ld(rb + (j + 2) * NWAVES, va);
                asm volatile("" ::: "memory");
                fin(rb + (j + 1) * NWAVES, vb); }
            __syncthreads();
        };
        int kk = 0;
        for (int L = bx; L < 1024; L += G, ++kk) { const int b = L >> 9, h = (L >> 5) & 15, qb = L & 31, kvh = h >> 2; const size_t qrow = (size_t)b * SEQ + qb * 256;
            if (kk == l1_slot) l1_copies();
            const unsigned char* Qp = Q8B + qrow * 2048 + h * 128; const unsigned char* Kp = K8B + (size_t)b * SKV * 512 + kvh * 128;
            float sh = mfixC;
            if (ATT_FORCE_PREPASS || !fixmax) sh = att::attn_rowmax(Qp, Kp, SKV, (char*)lds_raw);
            att::attn_dense_body3(Qp, Kp, V8TB + (size_t)(b * 4 + kvh) * 128 * SKV, GA + qrow * 2048 + h * 128, (bf16_t*)((unsigned char*)MIX + qrow * 6144 + h * 128), SKV, (char*)lds_raw, sh - 15.0f); }
        if (l1_slot >= kk) l1_copies();
    PH_END(8)
    SEAM(8);

    PH_BEGIN(9)
        pg8::Gemm g{MIX, WO0, 3072, 3072, 3072, 16}; pg8::StaticOrder S; S.init(MLAT, DM, G, bx); EpiDelta E{D0, MOD + 8192};
        pg8::gemm_phase<EpiDelta, pg8::StaticOrder, 2>(lds, g, S, E);
    PH_END(9)
    SEAM(9);

    PH_BEGIN(10)
        const int gw = bx * NWAVES + wave, NGW = G * NWAVES;
        modulate_rows<true>(x, D0, l1_norm_w, MOD + 3 * 12288, XN, gw, NGW, MLAT, lane);
    PH_END(10)
    SEAM(10);

    PH_BEGIN(11)
        pg8::Gemm g{XN, BT1, DM, DM, DM, 0}; pg8::StaticOrder S; S.init(MLAT, NIN1, G, bx);
        EpiConv E{M1, l1_conv_w, l1_conv_b, YE, PP, (LAS float*)(lds + EPI_OFF)};
        pg8::gemm_phase<EpiConv, pg8::StaticOrder>(lds, g, S, E);
    PH_END(11)
    SEAM(11);

    PH_BEGIN(12)
    PH_END(12)

    PH_BEGIN(13)
        { int tid_f = threadIdx.x; asm volatile("" : "+v"(tid_f));
          const int pm_lo = G == 256 ? 8 * (bx & 7) + ((bx >> 3) & 7) : 0, pm_hi = G == 256 ? pm_lo + 1 : 64;
          for (int pm = pm_lo; pm < pm_hi; ++pm)
              for (int idx = tid_f; idx < 2048; idx += NTHREADS) { const int side = idx >> 10, ch = (idx & 1023) * 4;
                  if (side == 0 ? (pm & 31) == 0 : (pm & 31) == 31) continue;
                  const size_t eo = ((size_t)pm * 2 + side) * 4096 + ch;
                  const f32x4 p = *(const f32x4*)(PP + 2 * eo), cv = *(const f32x4*)(PP + 2 * eo + 4);
                  const f32x4 yn = side == 0 ? *(const f32x4*)(YE + ((size_t)(pm - 1) * 2 + 1) * 4096 + ch) : *(const f32x4*)(YE + ((size_t)(pm + 1) * 2 + 0) * 4096 + ch);
                  const f32x4 w = *(const f32x4*)(l1_conv_w + (side == 0 ? 0 : 8192) + ch);
                  const f32x4 o = p * (cv + w * yn); u32x2 pk; pk.x = cvt_pk_bf16(o[0], o[1]); pk.y = cvt_pk_bf16(o[2], o[3]);
                  *(u32x2*)(M1 + ((size_t)pm * 256 + (side ? 255 : 0)) * 4096 + ch) = pk; }
          asm volatile("s_waitcnt vmcnt(0)" ::: "memory"); __syncthreads(); }
        pg8::Gemm g{M1, WO1, DM, DM, DM, 0}; pg8::StaticOrder S; S.init(MLAT, DM, G, bx); EpiOut E{x, D0, out, MOD + 3 * 12288 + 8192};
        pg8::gemm_phase<EpiOut, pg8::StaticOrder>(lds, g, S, E);
    PH_END(13)
#undef IN
#undef SEAM
}

constexpr int NPHASES = 14;
extern "C" void kernel_launch(void* const* d_in, const int* in_sizes, int n_in, void* d_out, int out_size, void* d_ws, size_t ws_size, hipStream_t stream) {
    static int grid = 0;
    if (grid == 0) {
        if (n_in != 35 || in_sizes[0] != MLAT * DM || out_size != MLAT * DM || ws_size < WS_END) {
            fprintf(stderr, "kernel_launch: shape mismatch: n_in %d in0 %d out %d ws %zu (need %zu)\n", n_in, n_in > 0 ? in_sizes[0] : -1, out_size, ws_size, (size_t)WS_END); grid = -1; return; }
        int dev = 0, cus = 0, per_cu = 0;
        if (hipGetDevice(&dev) != hipSuccess || hipDeviceGetAttribute(&cus, hipDeviceAttributeMultiprocessorCount, dev) != hipSuccess) { grid = -1; return; }
        if (hipFuncSetAttribute((const void*)fwd_kernel, hipFuncAttributeMaxDynamicSharedMemorySize, LDS_BYTES) != hipSuccess) { fprintf(stderr, "kernel_launch: hipFuncSetAttribute failed\n"); grid = -1; return; }
        if (hipOccupancyMaxActiveBlocksPerMultiprocessor(&per_cu, (const void*)fwd_kernel, NTHREADS, LDS_BYTES) != hipSuccess || per_cu < 1)
            fprintf(stderr, "kernel_launch: occupancy query reports %d workgroups per CU\n", per_cu);
        (void)hipGetLastError();
        grid = cus;
    }
    if (grid < 0) return;
    if (hipMemsetAsync((char*)d_ws + WS_CTL, 0, CTL_ZERO_BYTES, stream) != hipSuccess) { fprintf(stderr, "kernel_launch: memset failed\n"); return; }
    Args a{};
    for (int i = 0; i < 35; ++i) a.in[i] = (const float*)d_in[i];
    a.out = (float*)d_out; a.ws = (unsigned char*)d_ws;
#if MK_ONE_LAUNCH
    a.ph_lo = 0; a.ph_hi = NPHASES;
    hipLaunchKernelGGL(fwd_kernel, dim3(grid), dim3(NTHREADS), LDS_BYTES, stream, a);
#else
    for (int ph = 0; ph < NPHASES; ++ph) { a.ph_lo = ph; a.ph_hi = ph + 1; hipLaunchKernelGGL(fwd_kernel, dim3(grid), dim3(NTHREADS), LDS_BYTES, stream, a); }
#endif
    const hipError_t le = hipPeekAtLastError();
    if (le != hipSuccess) fprintf(stderr, "kernel_launch: launch failed: %s\n", hipGetErrorName(le));
}
```
